# Optimizing an MI355X kernel written in HIP

```python
import math
import jax
import jax.numpy as jnp
from jax import lax
import numpy as np


D_MODEL = 1024
BATCH = 1
SEQ = 16384
DEPTH = 1

HEAD_DIM = 64
NSA_HEADS = 8
NSA_GROUPS = 2
NSA_REP = NSA_HEADS // NSA_GROUPS
CMP_BLOCK = 32
CMP_STRIDE = 16
CMP_HIDDEN = 256
SEL_BLOCK = 64
SEL_TOPK = 16
NSA_WINDOW = 512
NSA_QBLOCK = 128
SWA_HEADS = 8
SWA_KV_HEADS = 2
SWA_REP = SWA_HEADS // SWA_KV_HEADS
SWA_WINDOW = 128
SWA_QBLOCK = 128
D_FF = 4 * D_MODEL
NUM_BUCKETS = 32
MAX_DISTANCE = 1024
N_BIAS_HEADS = NSA_HEADS + SWA_HEADS
RMS_EPS = 1e-6

NSA_Q_DIM = NSA_HEADS * HEAD_DIM
NSA_KV_DIM = NSA_GROUPS * HEAD_DIM
SWA_Q_DIM = SWA_HEADS * HEAD_DIM
SWA_KV_DIM = SWA_KV_HEADS * HEAD_DIM
IN_SIZES = (NSA_Q_DIM,) + (NSA_KV_DIM,) * 6 + (3 * NSA_HEADS, SWA_Q_DIM, SWA_KV_DIM, SWA_KV_DIM, D_MODEL, D_MODEL)
IN_DIM = int(sum(IN_SIZES))
IN_OFFSETS = tuple(int(o) for o in np.cumsum(IN_SIZES)[:-1])

kernel_name = 'hybrid_nsa_swa_sink_gated_block'


def rms_norm(x, g):
    xf = x.astype(jnp.float32)
    y = xf * lax.rsqrt(jnp.mean(xf * xf, axis=-1, keepdims=True) + RMS_EPS)
    return (y * g.astype(jnp.float32)).astype(x.dtype)


def t5_bucket(dist):
    max_exact = NUM_BUCKETS // 2
    d = jnp.maximum(dist, 0)
    df = jnp.maximum(d, 1).astype(jnp.float32)
    large = max_exact + (jnp.log(df / max_exact) / math.log(MAX_DISTANCE / max_exact)
                         * (NUM_BUCKETS - max_exact)).astype(jnp.int32)
    large = jnp.minimum(large, NUM_BUCKETS - 1)
    return jnp.where(d < max_exact, d, large)


def masked_softmax(s, mask):
    s = jnp.where(mask, s.astype(jnp.float32), -jnp.inf)
    m = jnp.max(s, axis=-1, keepdims=True)
    m = jnp.where(jnp.isfinite(m), m, 0.0)
    e = jnp.exp(s - m)
    return e / jnp.maximum(jnp.sum(e, axis=-1, keepdims=True), 1e-30)


def compress_kv(kv, pos, w1, w2):
    b, s, g, d = kv.shape
    n_cmp = (s - CMP_BLOCK) // CMP_STRIDE + 1
    kb = kv.reshape(b, s // CMP_STRIDE, CMP_STRIDE, g, d)
    blocks = jnp.concatenate([kb[:, o:o + n_cmp] for o in range(CMP_BLOCK // CMP_STRIDE)], axis=2)
    blocks = blocks + pos[None, None, :, None, :]
    flat = blocks.transpose(0, 1, 3, 2, 4).reshape(b, n_cmp, g, CMP_BLOCK * d)
    return jax.nn.gelu(flat @ w1) @ w2


def nsa_attention(q, kc, vc, k_slc, v_slc, k_win, v_win, gates, bias_tab):
    b, s, g, r, d = q.shape
    scale = d ** -0.5
    n_cmp = kc.shape[1]
    n_sel = s // SEL_BLOCK
    topk = min(SEL_TOPK, n_sel)
    n_chunks = s // NSA_QBLOCK
    ratio = SEL_BLOCK // CMP_STRIDE
    pad_front = CMP_BLOCK // CMP_STRIDE - 1
    pad_back = n_sel * ratio - n_cmp
    ks_blk = k_slc.reshape(b, n_sel, SEL_BLOCK, g, d).transpose(0, 3, 1, 2, 4)
    vs_blk = v_slc.reshape(b, n_sel, SEL_BLOCK, g, d).transpose(0, 3, 1, 2, 4)
    kw = jnp.pad(k_win, ((0, 0), (NSA_WINDOW, 0), (0, 0), (0, 0)))
    vw = jnp.pad(v_win, ((0, 0), (NSA_WINDOW, 0), (0, 0), (0, 0)))
    cmp_end = jnp.arange(n_cmp) * CMP_STRIDE + CMP_BLOCK - 1
    b_idx = jnp.arange(b)[:, None, None, None]
    g_idx = jnp.arange(g)[None, :, None, None]
    win_off = jnp.arange(NSA_QBLOCK + NSA_WINDOW) - NSA_WINDOW
    sel_off = jnp.arange(SEL_BLOCK)
    blk_ids = jnp.arange(n_sel)

    def chunk(args):
        qc, gc, ci = args
        t = ci * NSA_QBLOCK + jnp.arange(NSA_QBLOCK)
        sc = jnp.einsum('bqgrd,bngd->bgrqn', qc, kc).astype(jnp.float32) * scale
        pc = masked_softmax(sc, cmp_end[None, :] <= t[:, None])
        oc = jnp.einsum('bgrqn,bngd->bqgrd', pc.astype(vc.dtype), vc)
        pg = jnp.pad(pc.sum(axis=2), ((0, 0), (0, 0), (0, 0), (pad_front, pad_back)))
        ps = sum(pg[..., o:o + n_sel * ratio:ratio] for o in range(ratio + pad_front))
        cur = t // SEL_BLOCK
        valid = blk_ids[None, :] <= cur[:, None]
        forced = (blk_ids[None, :] == 0) | (blk_ids[None, :] == cur[:, None]) | (blk_ids[None, :] == cur[:, None] - 1)
        score = jnp.where(valid, jnp.where(forced, jnp.inf, ps), -jnp.inf)
        _, idx = lax.top_k(score, topk)
        kg = ks_blk[b_idx, g_idx, idx]
        vg = vs_blk[b_idx, g_idx, idx]
        pos = idx[..., None] * SEL_BLOCK + sel_off
        tq = t[None, None, :, None, None]
        bias_s = bias_tab[t5_bucket(tq - pos), g_idx[..., None]]
        ss = jnp.einsum('bqgrd,bgqjkd->bgrqjk', qc, kg).astype(jnp.float32) * scale + jnp.moveaxis(bias_s, -1, 2)
        n_keys = topk * SEL_BLOCK
        mask_s = (pos <= tq).reshape(b, g, 1, NSA_QBLOCK, n_keys)
        p_s = masked_softmax(ss.reshape(b, g, r, NSA_QBLOCK, n_keys), mask_s)
        o_s = jnp.einsum('bgrqn,bgqnd->bqgrd', p_s.astype(vg.dtype), vg.reshape(b, g, NSA_QBLOCK, n_keys, d))
        kwc = lax.dynamic_slice_in_dim(kw, ci * NSA_QBLOCK, NSA_QBLOCK + NSA_WINDOW, axis=1)
        vwc = lax.dynamic_slice_in_dim(vw, ci * NSA_QBLOCK, NSA_QBLOCK + NSA_WINDOW, axis=1)
        spos = ci * NSA_QBLOCK + win_off
        dist = t[:, None] - spos[None, :]
        mask_w = (dist >= 0) & (dist < NSA_WINDOW) & (spos[None, :] >= 0)
        bias_w = jnp.transpose(bias_tab[t5_bucket(dist)], (2, 3, 0, 1))
        sw = jnp.einsum('bqgrd,bkgd->bgrqk', qc, kwc).astype(jnp.float32) * scale + bias_w
        p_w = masked_softmax(sw, mask_w)
        o_w = jnp.einsum('bgrqk,bkgd->bqgrd', p_w.astype(vwc.dtype), vwc)
        gs = jax.nn.sigmoid(gc.astype(jnp.float32)).astype(qc.dtype)
        return gs[..., 0:1] * oc + gs[..., 1:2] * o_s + gs[..., 2:3] * o_w

    q_ch = q.reshape(b, n_chunks, NSA_QBLOCK, g, r, d).swapaxes(0, 1)
    g_ch = gates.reshape(b, n_chunks, NSA_QBLOCK, g, r, 3).swapaxes(0, 1)
    out = lax.map(chunk, (q_ch, g_ch, jnp.arange(n_chunks)))
    return out.swapaxes(0, 1).reshape(b, s, g * r * d)


def swa_sink_attention(q, k, v, sinks, bias_tab):
    b, s, g, r, d = q.shape
    scale = d ** -0.5
    nb = s // SWA_QBLOCK
    qb = q.reshape(b, nb, SWA_QBLOCK, g, r, d)
    kb = k.reshape(b, nb, SWA_QBLOCK, g, d)
    vb = v.reshape(b, nb, SWA_QBLOCK, g, d)
    pad = ((0, 0), (1, 0), (0, 0), (0, 0), (0, 0))
    kk = jnp.concatenate([jnp.pad(kb, pad)[:, :-1], kb], axis=2)
    vv = jnp.concatenate([jnp.pad(vb, pad)[:, :-1], vb], axis=2)
    qi = jnp.arange(SWA_QBLOCK)[:, None]
    ki = jnp.arange(2 * SWA_QBLOCK)[None, :]
    dist = qi - ki + SWA_QBLOCK
    band = (dist >= 0) & (dist < SWA_WINDOW)
    first = (jnp.arange(nb) > 0)[:, None, None] | (ki >= SWA_QBLOCK)[None]
    mask = (band[None] & first)[None, :, None, None]
    bias = jnp.transpose(bias_tab[t5_bucket(dist)], (2, 3, 0, 1))
    sc = jnp.einsum('bnqgrd,bnkgd->bngrqk', qb, kk).astype(jnp.float32) * scale + bias
    sc = jnp.where(mask, sc, -jnp.inf)
    sink = sinks.astype(jnp.float32)[None, None, :, :, None, None]
    m = jnp.maximum(jnp.max(sc, axis=-1, keepdims=True), sink)
    e = jnp.exp(sc - m)
    p = e / (jnp.sum(e, axis=-1, keepdims=True) + jnp.exp(sink - m))
    o = jnp.einsum('bngrqk,bnkgd->bnqgrd', p.astype(vv.dtype), vv)
    return o.reshape(b, s, g * r * d)


def setup_inputs(seed: int = 0) -> dict:
    key = jax.random.key(seed)
    ks = jax.random.split(key, 20)
    nrm = lambda k, shape, scale: jax.random.normal(k, shape, jnp.float32) * scale
    gain = lambda k: 1.0 + nrm(k, (DEPTH, D_MODEL), 0.05)
    cin = CMP_BLOCK * HEAD_DIM
    return {
        'x': nrm(ks[0], (BATCH, SEQ, D_MODEL), 1.0),
        'norm_mix_pre': gain(ks[1]),
        'norm_mix_post': gain(ks[2]),
        'norm_mlp_pre': gain(ks[3]),
        'norm_mlp_post': gain(ks[4]),
        'w_in': nrm(ks[5], (DEPTH, D_MODEL, IN_DIM), D_MODEL ** -0.5),
        'cmp_pos_k': nrm(ks[6], (DEPTH, CMP_BLOCK, HEAD_DIM), 0.5),
        'cmp_w1_k': nrm(ks[7], (DEPTH, cin, CMP_HIDDEN), cin ** -0.5),
        'cmp_w2_k': nrm(ks[8], (DEPTH, CMP_HIDDEN, HEAD_DIM), CMP_HIDDEN ** -0.5),
        'cmp_pos_v': nrm(ks[9], (DEPTH, CMP_BLOCK, HEAD_DIM), 0.5),
        'cmp_w1_v': nrm(ks[10], (DEPTH, cin, CMP_HIDDEN), cin ** -0.5),
        'cmp_w2_v': nrm(ks[11], (DEPTH, CMP_HIDDEN, HEAD_DIM), CMP_HIDDEN ** -0.5),
        'attn_sinks': nrm(ks[12], (DEPTH, SWA_HEADS), 0.5),
        'rel_bias': nrm(ks[13], (NUM_BUCKETS, N_BIAS_HEADS), 0.5),
        'w_up_nsa': nrm(ks[14], (DEPTH, NSA_Q_DIM, D_MODEL), NSA_Q_DIM ** -0.5),
        'w_up_swa': nrm(ks[15], (DEPTH, SWA_Q_DIM, D_MODEL), SWA_Q_DIM ** -0.5),
        'w_out': nrm(ks[16], (DEPTH, D_MODEL, D_MODEL), D_MODEL ** -0.5),
        'w_mlp_in': nrm(ks[17], (DEPTH, D_MODEL, D_FF), D_MODEL ** -0.5),
        'w_mlp_out': nrm(ks[18], (DEPTH, D_FF, D_MODEL), D_FF ** -0.5),
    }


def reference(x, norm_mix_pre, norm_mix_post, norm_mlp_pre, norm_mlp_post, w_in,
              cmp_pos_k, cmp_w1_k, cmp_w2_k, cmp_pos_v, cmp_w1_v, cmp_w2_v,
              attn_sinks, rel_bias, w_up_nsa, w_up_swa, w_out, w_mlp_in, w_mlp_out):
    b, s, _ = x.shape
    bias_nsa = rel_bias[:, :NSA_HEADS].reshape(NUM_BUCKETS, NSA_GROUPS, NSA_REP)
    bias_swa = rel_bias[:, NSA_HEADS:].reshape(NUM_BUCKETS, SWA_KV_HEADS, SWA_REP)
    h = x
    for l in range(DEPTH):
        u = rms_norm(h, norm_mix_pre[l])
        (q_n, kc_n, vc_n, ks_n, vs_n, kw_n, vw_n, g_n,
         q_s, k_s, v_s, gate_a, gate_b) = jnp.split(u @ w_in[l], IN_OFFSETS, axis=-1)
        kvr = lambda t_: t_.reshape(b, s, NSA_GROUPS, HEAD_DIM)
        kc = compress_kv(kvr(kc_n), cmp_pos_k[l], cmp_w1_k[l], cmp_w2_k[l])
        vc = compress_kv(kvr(vc_n), cmp_pos_v[l], cmp_w1_v[l], cmp_w2_v[l])
        o_a = nsa_attention(q_n.reshape(b, s, NSA_GROUPS, NSA_REP, HEAD_DIM), kc, vc,
                            kvr(ks_n), kvr(vs_n), kvr(kw_n), kvr(vw_n),
                            g_n.reshape(b, s, NSA_GROUPS, NSA_REP, 3), bias_nsa)
        o_b = swa_sink_attention(q_s.reshape(b, s, SWA_KV_HEADS, SWA_REP, HEAD_DIM),
                                 k_s.reshape(b, s, SWA_KV_HEADS, HEAD_DIM),
                                 v_s.reshape(b, s, SWA_KV_HEADS, HEAD_DIM),
                                 attn_sinks[l].reshape(SWA_KV_HEADS, SWA_REP), bias_swa)
        y = jax.nn.sigmoid(gate_a) * (o_a @ w_up_nsa[l]) + jax.nn.sigmoid(gate_b) * (o_b @ w_up_swa[l])
        h = h + rms_norm(y @ w_out[l], norm_mix_post[l])
        u = rms_norm(h, norm_mlp_pre[l])
        f = jnp.square(jax.nn.relu(u @ w_mlp_in[l])) @ w_mlp_out[l]
        h = h + rms_norm(f, norm_mlp_post[l])
    return h
```

```cpp
#include <hip/hip_runtime.h>
#include <hip/hip_cooperative_groups.h>
#include <cstdio>
#include <cstdint>
namespace cg = cooperative_groups;

#ifndef N_LAUNCH_MODE
#define N_LAUNCH_MODE 0
#endif

#define LDSP __attribute__((address_space(3)))
typedef _Float16 h16;
typedef _Float16 h16x8 __attribute__((ext_vector_type(8)));
typedef _Float16 h16x4 __attribute__((ext_vector_type(4)));
typedef float f32x4 __attribute__((ext_vector_type(4)));
typedef unsigned u32x4 __attribute__((ext_vector_type(4)));

constexpr int S = 16384, D = 1024, FF = 4096, NIN = 4120;
constexpr int PP = 4096;
constexpr int C_QN = 0, C_KC = 512, C_VC = 640, C_KS = 768, C_VS = 896, C_KW = 1024, C_VW = 1152, C_QS = 1280, C_KSW = 1792, C_VSW = 1920, C_GA = 2048, C_GB = 3072;
constexpr int NCMP = 1023;
constexpr float EPS = 1e-6f;
constexpr int NWAVES = 8, NTHR = 512;
constexpr int LDS_BYTES = 147456;

constexpr size_t MiB = 1u << 20;
constexpr size_t WS_CTL = 0;
constexpr size_t WS_WIN = 1 * MiB;
constexpr size_t WS_W1 = 9 * MiB;
constexpr size_t WS_W2 = 17 * MiB;
constexpr size_t WS_WOUT = 25 * MiB;
constexpr size_t WS_WUA = 27 * MiB;
constexpr size_t WS_WUB = 28 * MiB;
constexpr size_t WS_CW1K = 29 * MiB;
constexpr size_t WS_CW1V = 30 * MiB;
constexpr size_t WS_SMALL = 31 * MiB;
constexpr size_t WS_WG = WS_SMALL, WS_CW2K = WS_SMALL + 65536, WS_CW2V = WS_CW2K + 32768, WS_CBP = WS_CW2V + 32768;
constexpr size_t WS_R1 = 32 * MiB;
constexpr size_t WS_OA = 64 * MiB;
constexpr size_t WS_OB = 80 * MiB;
constexpr size_t WS_Z2 = 32 * MiB;
constexpr size_t WS_R0 = 96 * MiB;
constexpr size_t WS_VST = 224 * MiB;
constexpr size_t WS_VWT = 228 * MiB;
constexpr size_t WS_VBT = 232 * MiB;
constexpr size_t WS_KC = 236 * MiB;
constexpr size_t WS_VCR = WS_KC + 262144;
constexpr size_t WS_VCT = WS_VCR + 262144;
constexpr size_t WS_RSTDX = 237 * MiB;
constexpr size_t WS_RSTD1 = WS_RSTDX + 65536;
constexpr size_t WS_IDX = 238 * MiB;

struct Args { const float* in[19]; float* out; unsigned char* ws; int ph_lo, ph_hi, coop, pad; };

__device__ __forceinline__ float wave_sum(float v) {
#pragma unroll
    for (int o = 32; o >= 1; o >>= 1) v += __shfl_xor(v, o);
    return v;
}
__device__ __forceinline__ float wave_max(float v) {
#pragma unroll
    for (int o = 32; o >= 1; o >>= 1) v = fmaxf(v, __shfl_xor(v, o));
    return v;
}
__device__ __forceinline__ void lds_wait() { asm volatile("s_waitcnt lgkmcnt(0)" ::: "memory"); }
__device__ __forceinline__ unsigned pkh(float a, float b) { h16 x = (h16)a, y = (h16)b; return (unsigned)__builtin_bit_cast(unsigned short, x) | ((unsigned)__builtin_bit_cast(unsigned short, y) << 16); }
__device__ __forceinline__ float sigmoidf_(float x) { return 1.0f / (1.0f + __expf(-x)); }

struct Ctx {
    LDSP unsigned char* lds; int tid, lane, wave, gw, NGW;
    const float* in[19]; float* out; unsigned char* ws;
};

__device__ __forceinline__ void transpose_item(const float* W, int ldw, int col0, const float* scale, int K, h16* WT, int item, int nblk, LDSP float* scr, int lane) {
    const int kb = item / nblk, nb = item % nblk, k0 = 64 * kb, n0 = 32 * nb;
#pragma unroll 8
    for (int i = 0; i < 32; ++i) { const int kk = 2 * i + (lane >> 5); float v = W[(size_t)(k0 + kk) * ldw + col0 + n0 + (lane & 31)]; if (scale) v *= scale[k0 + kk]; scr[kk * 33 + (lane & 31)] = v; }
    lds_wait();
    const int c = lane & 7;
#pragma unroll
    for (int j = 0; j < 4; ++j) { const int n = (lane >> 3) + 8 * j; const LDSP float* s = scr + (8 * c) * 33 + n;
        u32x4 o; o.x = pkh(s[0 * 33], s[1 * 33]); o.y = pkh(s[2 * 33], s[3 * 33]); o.z = pkh(s[4 * 33], s[5 * 33]); o.w = pkh(s[6 * 33], s[7 * 33]);
        *(u32x4*)(WT + (size_t)(n0 + n) * K + k0 + 8 * c) = o; }
    lds_wait();
}

__device__ __forceinline__ void phase_prologue(Ctx& C) {
    LDSP float* scr = (LDSP float*)(C.lds + C.wave * 16384);
    const float* w_in = C.in[5];
    constexpr int I_WIN_A = 16 * 40, I_WIN_B = 16 * 88, I_WG = 16, I_UP = 8 * 32, I_OUT = 16 * 32, I_W1 = 16 * 128, I_W2 = 64 * 32, I_C1 = 32 * 8, I_C2 = 4 * 2;
    constexpr int NITEMS = I_WIN_A + I_WIN_B + I_WG + 2 * I_UP + I_OUT + I_W1 + I_W2 + 2 * I_C1 + 2 * I_C2;
    for (int it = C.gw; it < NITEMS; it += C.NGW) {
        int r = it;
        if (r < I_WIN_A) { transpose_item(w_in, NIN, 0, C.in[1], D, (h16*)(C.ws + WS_WIN), r, 40, scr, C.lane); continue; } r -= I_WIN_A;
        if (r < I_WIN_B) { transpose_item(w_in, NIN, 1304, C.in[1], D, (h16*)(C.ws + WS_WIN) + (size_t)1280 * D, r, 88, scr, C.lane); continue; } r -= I_WIN_B;
        if (r < I_WG) { transpose_item(w_in, NIN, 1280, C.in[1], D, (h16*)(C.ws + WS_WG), r, 1, scr, C.lane); continue; } r -= I_WG;
        if (r < I_UP) { transpose_item(C.in[14], D, 0, nullptr, 512, (h16*)(C.ws + WS_WUA), r, 32, scr, C.lane); continue; } r -= I_UP;
        if (r < I_UP) { transpose_item(C.in[15], D, 0, nullptr, 512, (h16*)(C.ws + WS_WUB), r, 32, scr, C.lane); continue; } r -= I_UP;
        if (r < I_OUT) { transpose_item(C.in[16], D, 0, nullptr, D, (h16*)(C.ws + WS_WOUT), r, 32, scr, C.lane); continue; } r -= I_OUT;
        if (r < I_W1) { transpose_item(C.in[17], FF, 0, C.in[3], D, (h16*)(C.ws + WS_W1), r, 128, scr, C.lane); continue; } r -= I_W1;
        if (r < I_W2) { transpose_item(C.in[18], D, 0, nullptr, FF, (h16*)(C.ws + WS_W2), r, 32, scr, C.lane); continue; } r -= I_W2;
        if (r < I_C1) { transpose_item(C.in[7], 256, 0, nullptr, 2048, (h16*)(C.ws + WS_CW1K), r, 8, scr, C.lane); continue; } r -= I_C1;
        if (r < I_C1) { transpose_item(C.in[10], 256, 0, nullptr, 2048, (h16*)(C.ws + WS_CW1V), r, 8, scr, C.lane); continue; } r -= I_C1;
        if (r < I_C2) { transpose_item(C.in[8], 64, 0, nullptr, 256, (h16*)(C.ws + WS_CW2K), r, 2, scr, C.lane); continue; } r -= I_C2;
        transpose_item(C.in[11], 64, 0, nullptr, 256, (h16*)(C.ws + WS_CW2V), r, 2, scr, C.lane);
    }
    for (int u = C.gw; u < 16 * 2 * 4; u += C.NGW) {
        const int s = u >> 3, kv = (u >> 2) & 1, nb = u & 3, n = nb * 64 + C.lane;
        const float* pos = C.in[kv ? 9 : 6]; const float* w1 = C.in[kv ? 10 : 7];
        float acc = 0.f;
        for (int k = s * 128; k < s * 128 + 128; ++k) acc += pos[k] * w1[(size_t)k * 256 + n];
        ((float*)(C.ws + WS_CBP))[(s * 2 + kv) * 256 + n] = acc;
    }
    h16* xh = (h16*)(C.ws + WS_R1); float* rstdx = (float*)(C.ws + WS_RSTDX);
    for (int m = C.gw; m < S; m += C.NGW) {
        const f32x4* xr = (const f32x4*)(C.in[0] + (size_t)m * D) + C.lane;
        f32x4 v[4]; float s = 0.f;
#pragma unroll
        for (int j = 0; j < 4; ++j) { v[j] = xr[64 * j]; s += (v[j].x * v[j].x + v[j].y * v[j].y) + (v[j].z * v[j].z + v[j].w * v[j].w); }
        s = wave_sum(s);
        if (C.lane == 0) rstdx[m] = 1.0f / sqrtf(s * (1.0f / D) + EPS);
        unsigned long long* o8 = (unsigned long long*)(xh + (size_t)m * D) + C.lane;
#pragma unroll
        for (int j = 0; j < 4; ++j) o8[64 * j] = (unsigned long long)pkh(v[j].x, v[j].y) | ((unsigned long long)pkh(v[j].z, v[j].w) << 32);
    }
}

template <class Epi>
__device__ __forceinline__ void ngemm(const h16* A1, int lda1, const h16* B1, int K1, const h16* A2, int lda2, const h16* B2, int K2, int M, int N, const Epi& epi, int gw, int NGW, int lane) {
    const int tn_cnt = N / 32, tiles = (M / 32) * tn_cnt, fr = lane & 15, fq = lane >> 4;
    for (int tile = gw; tile < tiles; tile += NGW) {
        const int tm = tile / tn_cnt, tn = tile % tn_cnt;
        f32x4 acc1[2][2], acc2[2][2];
#pragma unroll
        for (int i = 0; i < 2; ++i)
#pragma unroll
            for (int j = 0; j < 2; ++j) { acc1[i][j] = (f32x4){0.f, 0.f, 0.f, 0.f}; acc2[i][j] = (f32x4){0.f, 0.f, 0.f, 0.f}; }
        {
            const h16* a = A1 + (size_t)(tm * 32 + fr) * lda1 + 8 * fq; const h16* b = B1 + (size_t)(tn * 32 + fr) * K1 + 8 * fq;
            for (int k = 0; k < K1; k += 32) {
                const h16x8 a0 = *(const h16x8*)(a + k), a1 = *(const h16x8*)(a + (size_t)16 * lda1 + k);
                const h16x8 b0 = *(const h16x8*)(b + k), b1 = *(const h16x8*)(b + (size_t)16 * K1 + k);
                acc1[0][0] = __builtin_amdgcn_mfma_f32_16x16x32_f16(a0, b0, acc1[0][0], 0, 0, 0);
                acc1[0][1] = __builtin_amdgcn_mfma_f32_16x16x32_f16(a0, b1, acc1[0][1], 0, 0, 0);
                acc1[1][0] = __builtin_amdgcn_mfma_f32_16x16x32_f16(a1, b0, acc1[1][0], 0, 0, 0);
                acc1[1][1] = __builtin_amdgcn_mfma_f32_16x16x32_f16(a1, b1, acc1[1][1], 0, 0, 0);
            }
        }
        if (K2 > 0) {
            const h16* a = A2 + (size_t)(tm * 32 + fr) * lda2 + 8 * fq; const h16* b = B2 + (size_t)(tn * 32 + fr) * K2 + 8 * fq;
            for (int k = 0; k < K2; k += 32) {
                const h16x8 a0 = *(const h16x8*)(a + k), a1 = *(const h16x8*)(a + (size_t)16 * lda2 + k);
                const h16x8 b0 = *(const h16x8*)(b + k), b1 = *(const h16x8*)(b + (size_t)16 * K2 + k);
                acc2[0][0] = __builtin_amdgcn_mfma_f32_16x16x32_f16(a0, b0, acc2[0][0], 0, 0, 0);
                acc2[0][1] = __builtin_amdgcn_mfma_f32_16x16x32_f16(a0, b1, acc2[0][1], 0, 0, 0);
                acc2[1][0] = __builtin_amdgcn_mfma_f32_16x16x32_f16(a1, b0, acc2[1][0], 0, 0, 0);
                acc2[1][1] = __builtin_amdgcn_mfma_f32_16x16x32_f16(a1, b1, acc2[1][1], 0, 0, 0);
            }
        }
#pragma unroll
        for (int i = 0; i < 2; ++i)
#pragma unroll
            for (int j = 0; j < 2; ++j)
#pragma unroll
                for (int r = 0; r < 4; ++r) epi(tm * 32 + 16 * i + 4 * fq + r, tn * 32 + 16 * j + fr, acc1[i][j][r], acc2[i][j][r]);
    }
}

struct EpiProj {
    h16* proj; const float* rstd; h16* vsT; h16* vwT; h16* vbT;
    __device__ __forceinline__ void operator()(int row, int col, float v, float) const {
        const h16 o = (h16)(v * rstd[row]);
        proj[(size_t)row * PP + col] = o;
        if (col >= C_VS && col < C_VS + 128) vsT[(size_t)(col - C_VS) * S + row] = o;
        else if (col >= C_VW && col < C_VW + 128) vwT[(size_t)(col - C_VW) * S + row] = o;
        else if (col >= C_VSW && col < C_VSW + 128) vbT[(size_t)(col - C_VSW) * S + row] = o;
    }
};
struct EpiUp {
    h16* y; const h16* proj;
    __device__ __forceinline__ void operator()(int row, int col, float v1, float v2) const {
        const float ga = (float)proj[(size_t)row * PP + C_GA + col], gb = (float)proj[(size_t)row * PP + C_GB + col];
        y[(size_t)row * D + col] = (h16)(sigmoidf_(ga) * v1 + sigmoidf_(gb) * v2);
    }
};
struct EpiF32 { float* z; int ldz;
    __device__ __forceinline__ void operator()(int row, int col, float v, float) const { z[(size_t)row * ldz + col] = v; } };
struct EpiRelu2 { h16* a; const float* rstd;
    __device__ __forceinline__ void operator()(int row, int col, float v, float) const { float u = fmaxf(v * rstd[row], 0.f); a[(size_t)row * FF + col] = (h16)(u * u); } };

__device__ __forceinline__ float gelu_tanh(float x) { const float u = 0.7978845608028654f * (x + 0.044715f * x * x * x); return 0.5f * x * (1.0f + tanhf(u)); }
__device__ __forceinline__ void phase_compress_naive(Ctx& C) {
    LDSP float* hs = (LDSP float*)(C.lds + C.wave * 2048);
    const h16* proj = (const h16*)(C.ws + WS_R0);
    const float* cbp = (const float*)(C.ws + WS_CBP);
    for (int u = C.gw; u < 2 * NCMP * 2; u += C.NGW) {
        const int kv = u / (NCMP * 2), rem = u % (NCMP * 2), i = rem >> 1, g = rem & 1;
        const h16* w1T = (const h16*)(C.ws + (kv ? WS_CW1V : WS_CW1K)); const h16* w2T = (const h16*)(C.ws + (kv ? WS_CW2V : WS_CW2K));
        const int col = (kv ? C_VC : C_KC) + g * 64;
        float acc[4];
#pragma unroll
        for (int m = 0; m < 4; ++m) { float b = 0.f; for (int s = 0; s < 16; ++s) b += cbp[(s * 2 + kv) * 256 + C.lane + 64 * m]; acc[m] = b; }
        for (int j = 0; j < 32; ++j) {
            const h16* xr = proj + (size_t)(16 * i + j) * PP + col;
#pragma unroll
            for (int c = 0; c < 8; ++c) {
                const h16x8 xv = *(const h16x8*)(xr + 8 * c);
#pragma unroll
                for (int m = 0; m < 4; ++m) { const h16x8 wv = *(const h16x8*)(w1T + (size_t)(C.lane + 64 * m) * 2048 + j * 64 + 8 * c);
#pragma unroll
                    for (int e = 0; e < 8; ++e) acc[m] += (float)xv[e] * (float)wv[e]; }
            }
        }
#pragma unroll
        for (int m = 0; m < 4; ++m) hs[C.lane + 64 * m] = gelu_tanh(acc[m]);
        lds_wait();
        float o = 0.f;
        for (int n = 0; n < 256; n += 8) { const h16x8 wv = *(const h16x8*)(w2T + (size_t)C.lane * 256 + n);
#pragma unroll
            for (int e = 0; e < 8; ++e) o += hs[n + e] * (float)wv[e]; }
        lds_wait();
        if (kv == 0) ((h16*)(C.ws + WS_KC))[((size_t)i * 2 + g) * 64 + C.lane] = (h16)o;
        else { ((h16*)(C.ws + WS_VCR))[((size_t)i * 2 + g) * 64 + C.lane] = (h16)o; ((h16*)(C.ws + WS_VCT))[((size_t)g * 64 + C.lane) * 1024 + i] = (h16)o; }
    }
}

__device__ __forceinline__ void build_bucket_table(Ctx& C, LDSP unsigned char* buck) {
    for (int d = C.tid; d < 1024; d += NTHR) {
        int b;
        if (d < 16) b = d;
        else { const float x = (float)d / 16.0f; int l = 16 + (int)(logf(x) / 4.158883083359672f * 16.0f); b = l < 31 ? l : 31; }
        buck[d] = (unsigned char)b;
    }
    __syncthreads();
}

template <int MODE, int NB>
__device__ __forceinline__ void nattn(Ctx& C, int t, int g, LDSP float* scr, const LDSP unsigned char* buck, float (&o)[4]) {
    LDSP float* qs = scr; LDSP float* sc = scr + 256;
    const h16* proj = (const h16*)(C.ws + WS_R0);
    const int lane = C.lane;
    { const h16x4 qv = *(const h16x4*)(proj + (size_t)t * PP + (MODE == 3 ? C_QS : C_QN) + g * 256 + lane * 4);
#pragma unroll
      for (int e = 0; e < 4; ++e) qs[lane * 4 + e] = (float)qv[e]; }
    lds_wait();
    const int cur = t >> 6;
    const int nvalid = (t >= 31) ? (((t - 31) >> 4) + 1) : 0;
    const int nsel = (cur + 1) < 16 ? (cur + 1) : 16;
    const unsigned char* idxp = (const unsigned char*)(C.ws + WS_IDX) + ((size_t)t * 2 + g) * 16;
    const float* relb = C.in[13] + (MODE == 3 ? 8 : 0) + g * 4;
    const int kcol = (MODE == 1 ? C_KS : MODE == 2 ? C_KW : C_KSW) + g * 64;
    const int vcol = (MODE == 1 ? C_VS : MODE == 2 ? C_VW : C_VSW) + g * 64;
    const int nb = (MODE == 1) ? nsel : NB;
    float mx[4] = {-INFINITY, -INFINITY, -INFINITY, -INFINITY};
#pragma unroll 1
    for (int b = 0; b < nb; ++b) {
        int pos = 0; bool valid; const h16* krow;
        if (MODE == 0) { const int n = b * 64 + lane; valid = n < nvalid; krow = (const h16*)(C.ws + WS_KC) + ((size_t)(n < 1022 ? n : 1022) * 2 + g) * 64; }
        else {
            if (MODE == 1) { const int bid = (int)idxp[b]; pos = bid * 64 + lane; valid = (pos <= t); }
            else if (MODE == 2) { pos = t - 511 + 64 * b + lane; valid = pos >= 0; }
            else { pos = t - 127 + 64 * b + lane; valid = pos >= 0; }
            const int pc = pos < 0 ? 0 : pos;
            krow = proj + (size_t)pc * PP + kcol;
        }
        float a0 = 0.f, a1 = 0.f, a2 = 0.f, a3 = 0.f;
#pragma unroll 2
        for (int c = 0; c < 8; ++c) { const h16x8 kv = *(const h16x8*)(krow + 8 * c);
#pragma unroll
            for (int e = 0; e < 8; ++e) { const float kf = (float)kv[e]; a0 += qs[8 * c + e] * kf; a1 += qs[64 + 8 * c + e] * kf; a2 += qs[128 + 8 * c + e] * kf; a3 += qs[192 + 8 * c + e] * kf; } }
        float b0 = 0.f, b1 = 0.f, b2 = 0.f, b3 = 0.f;
        if (MODE != 0) { int dist = t - pos; dist = dist < 0 ? 0 : (dist > 1023 ? 1023 : dist); const int bk = buck[dist]; b0 = relb[bk * 16 + 0]; b1 = relb[bk * 16 + 1]; b2 = relb[bk * 16 + 2]; b3 = relb[bk * 16 + 3]; }
        a0 = valid ? a0 * 0.125f + b0 : -INFINITY; a1 = valid ? a1 * 0.125f + b1 : -INFINITY;
        a2 = valid ? a2 * 0.125f + b2 : -INFINITY; a3 = valid ? a3 * 0.125f + b3 : -INFINITY;
        sc[b * 64 + lane] = a0; sc[1024 + b * 64 + lane] = a1; sc[2048 + b * 64 + lane] = a2; sc[3072 + b * 64 + lane] = a3;
        mx[0] = fmaxf(mx[0], a0); mx[1] = fmaxf(mx[1], a1); mx[2] = fmaxf(mx[2], a2); mx[3] = fmaxf(mx[3], a3);
    }
    float inv[4];
#pragma unroll
    for (int h = 0; h < 4; ++h) {
        float m = wave_max(mx[h]);
        float sk = 0.f;
        if (MODE == 3) { sk = C.in[12][g * 4 + h]; m = fmaxf(m, sk); }
        const float ms = (m == -INFINITY) ? 0.f : m;
        float l = 0.f;
#pragma unroll 1
        for (int b = 0; b < nb; ++b) { const float e = __expf(sc[h * 1024 + b * 64 + lane] - ms); sc[h * 1024 + b * 64 + lane] = e; l += e; }
        l = wave_sum(l);
        if (MODE == 3) l += __expf(sk - ms);
        inv[h] = 1.0f / fmaxf(l, 1e-30f);
    }
    lds_wait();
    if (MODE == 0) {
        float scv[4];
#pragma unroll
        for (int c = 0; c < 4; ++c) { const int j = lane + 64 * c; float v = 0.f;
#pragma unroll 1
            for (int oo = 0; oo < 5; ++oo) { const int n = 4 * j + oo - 1; if (n >= 0 && n < NCMP) v += (sc[n] * inv[0] + sc[1024 + n] * inv[1]) + (sc[2048 + n] * inv[2] + sc[3072 + n] * inv[3]); }
            const bool val = j <= cur, forced = (j == 0) || (j == cur) || (j == cur - 1);
            scv[c] = val ? (forced ? INFINITY : v) : -INFINITY; }
        unsigned char* idxw = (unsigned char*)(C.ws + WS_IDX) + ((size_t)t * 2 + g) * 16;
#pragma unroll 1
        for (int it = 0; it < 16; ++it) {
            float bv = scv[0]; int bj = lane;
#pragma unroll
            for (int c = 1; c < 4; ++c) if (scv[c] > bv) { bv = scv[c]; bj = lane + 64 * c; }
#pragma unroll
            for (int of = 32; of >= 1; of >>= 1) { const float ov = __shfl_xor(bv, of); const int oj = __shfl_xor(bj, of); if (ov > bv || (ov == bv && oj < bj)) { bv = ov; bj = oj; } }
            if (bv == -INFINITY) bj = 0;
            if (lane == 0) idxw[it] = (unsigned char)bj;
#pragma unroll
            for (int c = 0; c < 4; ++c) if (bj == lane + 64 * c) scv[c] = -INFINITY;
        }
    }
    float x0 = 0.f, x1 = 0.f, x2 = 0.f, x3 = 0.f;
    if (MODE == 0) {
        const h16* V = (const h16*)(C.ws + WS_VCR) + g * 64 + lane;
#pragma unroll 2
        for (int n = 0; n < nvalid; ++n) { const float v = (float)V[(size_t)n * 128]; x0 += sc[n] * v; x1 += sc[1024 + n] * v; x2 += sc[2048 + n] * v; x3 += sc[3072 + n] * v; }
    } else {
#pragma unroll 1
        for (int b = 0; b < nb; ++b) {
            const int p0 = (MODE == 1) ? (int)idxp[b] * 64 : (MODE == 2 ? t - 511 + 64 * b : t - 127 + 64 * b);
#pragma unroll 2
            for (int i = 0; i < 64; ++i) { int pos = p0 + i; pos = pos < 0 ? 0 : (pos > S - 1 ? S - 1 : pos);
                const float v = (float)proj[(size_t)pos * PP + vcol + lane]; const int k = b * 64 + i;
                x0 += sc[k] * v; x1 += sc[1024 + k] * v; x2 += sc[2048 + k] * v; x3 += sc[3072 + k] * v; }
        }
    }
    o[0] = x0 * inv[0]; o[1] = x1 * inv[1]; o[2] = x2 * inv[2]; o[3] = x3 * inv[3];
    lds_wait();
}

__device__ __forceinline__ void phase_cmp_swa_naive(Ctx& C) {
    LDSP unsigned char* buck = C.lds; LDSP float* scr = (LDSP float*)(C.lds + 1024 + C.wave * 17408);
    build_bucket_table(C, buck);
    h16* oa = (h16*)(C.ws + WS_OA); h16* ob = (h16*)(C.ws + WS_OB);
    for (int u = C.gw; u < 2 * S * 2; u += C.NGW) {
        const int which = u / (S * 2), r = u % (S * 2), t = r >> 1, g = r & 1; float o[4];
        if (which == 0) { nattn<0, 16>(C, t, g, scr, buck, o);
#pragma unroll
            for (int h = 0; h < 4; ++h) oa[(size_t)t * 512 + (g * 4 + h) * 64 + C.lane] = (h16)o[h]; }
        else { nattn<3, 2>(C, t, g, scr, buck, o);
#pragma unroll
            for (int h = 0; h < 4; ++h) ob[(size_t)t * 512 + (g * 4 + h) * 64 + C.lane] = (h16)o[h]; }
    }
}
__device__ __forceinline__ void phase_selwin_naive(Ctx& C) {
    LDSP unsigned char* buck = C.lds; LDSP float* scr = (LDSP float*)(C.lds + 1024 + C.wave * 17408);
    build_bucket_table(C, buck);
    h16* oa = (h16*)(C.ws + WS_OA);
    const h16* xh = (const h16*)(C.ws + WS_R1); const h16* WgT = (const h16*)(C.ws + WS_WG); const float* rstdx = (const float*)(C.ws + WS_RSTDX);
    for (int u = C.gw; u < S * 2; u += C.NGW) {
        const int t = u >> 1, g = u & 1; float os[4], ow[4];
        nattn<1, 16>(C, t, g, scr, buck, os);
        nattn<2, 8>(C, t, g, scr, buck, ow);
        const h16x8 x0 = *(const h16x8*)(xh + (size_t)t * D + C.lane * 16), x1 = *(const h16x8*)(xh + (size_t)t * D + C.lane * 16 + 8);
        float gt[12]; const float rs = rstdx[t];
#pragma unroll
        for (int c = 0; c < 12; ++c) { const h16* wr = WgT + (size_t)(g * 12 + c) * D + C.lane * 16; const h16x8 w0 = *(const h16x8*)wr, w1 = *(const h16x8*)(wr + 8); float a = 0.f;
#pragma unroll
            for (int e = 0; e < 8; ++e) a += (float)x0[e] * (float)w0[e] + (float)x1[e] * (float)w1[e];
            gt[c] = sigmoidf_(wave_sum(a) * rs); }
#pragma unroll
        for (int h = 0; h < 4; ++h) { h16* p = oa + (size_t)t * 512 + (g * 4 + h) * 64 + C.lane; const float oc = (float)*p;
            *p = (h16)(gt[h * 3 + 0] * oc + gt[h * 3 + 1] * os[h] + gt[h * 3 + 2] * ow[h]); }
    }
}

__device__ __forceinline__ void phase_rows1(Ctx& C) {
    const float* z = (const float*)(C.ws + WS_R0); h16* h1h = (h16*)(C.ws + WS_R1); float* rstd1 = (float*)(C.ws + WS_RSTD1);
    for (int m = C.gw; m < S; m += C.NGW) {
        const f32x4* zr = (const f32x4*)(z + (size_t)m * D) + C.lane; const f32x4* xr = (const f32x4*)(C.in[0] + (size_t)m * D) + C.lane; const f32x4* gr = (const f32x4*)C.in[2] + C.lane;
        f32x4 v[4]; float s = 0.f;
#pragma unroll
        for (int j = 0; j < 4; ++j) { v[j] = zr[64 * j]; s += (v[j].x * v[j].x + v[j].y * v[j].y) + (v[j].z * v[j].z + v[j].w * v[j].w); }
        const float rs = 1.0f / sqrtf(wave_sum(s) * (1.0f / D) + EPS); float s2 = 0.f;
#pragma unroll
        for (int j = 0; j < 4; ++j) { v[j] = xr[64 * j] + v[j] * rs * gr[64 * j]; s2 += (v[j].x * v[j].x + v[j].y * v[j].y) + (v[j].z * v[j].z + v[j].w * v[j].w); }
        s2 = wave_sum(s2);
        if (C.lane == 0) rstd1[m] = 1.0f / sqrtf(s2 * (1.0f / D) + EPS);
        f32x4* orow = (f32x4*)(C.out + (size_t)m * D) + C.lane; unsigned long long* o8 = (unsigned long long*)(h1h + (size_t)m * D) + C.lane;
#pragma unroll
        for (int j = 0; j < 4; ++j) { orow[64 * j] = v[j]; o8[64 * j] = (unsigned long long)pkh(v[j].x, v[j].y) | ((unsigned long long)pkh(v[j].z, v[j].w) << 32); }
    }
}
__device__ __forceinline__ void phase_rows2(Ctx& C) {
    const float* z = (const float*)(C.ws + WS_Z2);
    for (int m = C.gw; m < S; m += C.NGW) {
        const f32x4* zr = (const f32x4*)(z + (size_t)m * D) + C.lane; f32x4* orow = (f32x4*)(C.out + (size_t)m * D) + C.lane; const f32x4* gr = (const f32x4*)C.in[4] + C.lane;
        f32x4 v[4]; float s = 0.f;
#pragma unroll
        for (int j = 0; j < 4; ++j) { v[j] = zr[64 * j]; s += (v[j].x * v[j].x + v[j].y * v[j].y) + (v[j].z * v[j].z + v[j].w * v[j].w); }
        const float rs = 1.0f / sqrtf(wave_sum(s) * (1.0f / D) + EPS);
#pragma unroll
        for (int j = 0; j < 4; ++j) orow[64 * j] = orow[64 * j] + v[j] * rs * gr[64 * j];
    }
}

constexpr int NPHASE = 11;
__global__ void __launch_bounds__(NTHR, 2) fwd_kernel(Args args) {
    extern __shared__ __attribute__((aligned(16))) unsigned char lds_raw[];
    Ctx C;
    C.lds = (LDSP unsigned char*)lds_raw; C.tid = threadIdx.x; C.lane = C.tid & 63; C.wave = __builtin_amdgcn_readfirstlane(C.tid >> 6);
    C.gw = blockIdx.x * NWAVES + C.wave; C.NGW = gridDim.x * NWAVES;
#pragma unroll
    for (int i = 0; i < 19; ++i) C.in[i] = args.in[i];
    C.out = args.out; C.ws = args.ws;
    const int lo = args.ph_lo, hi = args.ph_hi;
    unsigned char* ws = args.ws;
#define IN(k) (lo <= (k) && (k) < hi)
#define SEAM(k) do { if (IN(k) && IN((k) + 1)) { if (args.coop) { cg::this_grid().sync(); } } } while (0)
    if (IN(0)) { phase_prologue(C); } SEAM(0);
    if (IN(1)) { EpiProj E{(h16*)(ws + WS_R0), (const float*)(ws + WS_RSTDX), (h16*)(ws + WS_VST), (h16*)(ws + WS_VWT), (h16*)(ws + WS_VBT)};
        ngemm((const h16*)(ws + WS_R1), D, (const h16*)(ws + WS_WIN), D, nullptr, 0, nullptr, 0, S, PP, E, C.gw, C.NGW, C.lane); } SEAM(1);
    if (IN(2)) { phase_compress_naive(C); } SEAM(2);
    if (IN(3)) { __syncthreads(); phase_cmp_swa_naive(C); } SEAM(3);
    if (IN(4)) { __syncthreads(); phase_selwin_naive(C); } SEAM(4);
    if (IN(5)) { EpiUp E{(h16*)(ws + WS_R1), (const h16*)(ws + WS_R0)};
        ngemm((const h16*)(ws + WS_OA), 512, (const h16*)(ws + WS_WUA), 512, (const h16*)(ws + WS_OB), 512, (const h16*)(ws + WS_WUB), 512, S, D, E, C.gw, C.NGW, C.lane); } SEAM(5);
    if (IN(6)) { EpiF32 E{(float*)(ws + WS_R0), D};
        ngemm((const h16*)(ws + WS_R1), D, (const h16*)(ws + WS_WOUT), D, nullptr, 0, nullptr, 0, S, D, E, C.gw, C.NGW, C.lane); } SEAM(6);
    if (IN(7)) { phase_rows1(C); } SEAM(7);
    if (IN(8)) { EpiRelu2 E{(h16*)(ws + WS_R0), (const float*)(ws + WS_RSTD1)};
        ngemm((const h16*)(ws + WS_R1), D, (const h16*)(ws + WS_W1), D, nullptr, 0, nullptr, 0, S, FF, E, C.gw, C.NGW, C.lane); } SEAM(8);
    if (IN(9)) { EpiF32 E{(float*)(ws + WS_Z2), D};
        ngemm((const h16*)(ws + WS_R0), FF, (const h16*)(ws + WS_W2), FF, nullptr, 0, nullptr, 0, S, D, E, C.gw, C.NGW, C.lane); } SEAM(9);
    if (IN(10)) { phase_rows2(C); }
#undef IN
#undef SEAM
}

extern "C" void kernel_launch(void* const* d_in, const int* in_sizes, int n_in, void* d_out, int out_size, void* d_ws, size_t ws_size, hipStream_t stream) {
    static int grid = 0;
    if (grid == 0) {
        int dev = 0, cus = 0, per_cu = 0;
        hipGetDevice(&dev);
        hipDeviceGetAttribute(&cus, hipDeviceAttributeMultiprocessorCount, dev);
        hipFuncSetAttribute((const void*)fwd_kernel, hipFuncAttributeMaxDynamicSharedMemorySize, LDS_BYTES);
        hipOccupancyMaxActiveBlocksPerMultiprocessor(&per_cu, (const void*)fwd_kernel, NTHR, LDS_BYTES);
        if (per_cu < 1) { fprintf(stderr, "occupancy query says %d blocks/CU\n", per_cu); per_cu = 1; }
        grid = cus * 1;
        (void)hipGetLastError();
    }
    Args a{};
    for (int i = 0; i < 19; ++i) a.in[i] = (const float*)d_in[i];
    a.out = (float*)d_out; a.ws = (unsigned char*)d_ws;
#if N_LAUNCH_MODE == 1
    a.ph_lo = 0; a.ph_hi = NPHASE; a.coop = 1;
    void* kargs[] = {&a};
    hipError_t e = hipLaunchCooperativeKernel((const void*)fwd_kernel, dim3(grid), dim3(NTHR), kargs, LDS_BYTES, stream);
    if (e != hipSuccess) fprintf(stderr, "cooperative launch failed: %s (grid %d)\n", hipGetErrorString(e), grid);
#else
    for (int p = 0; p < NPHASE; ++p) {
        a.ph_lo = p; a.ph_hi = p + 1; a.coop = 0;
        hipLaunchKernelGGL(fwd_kernel, dim3(grid), dim3(NTHR), LDS_BYTES, stream, a);
    }
#endif
}
```

```cpp
#include <hip/hip_runtime.h>
#include <hip/hip_cooperative_groups.h>
#include <cstdio>
#include <cstdint>
namespace cg = cooperative_groups;

#ifndef N_LAUNCH_MODE
#define N_LAUNCH_MODE 1
#endif

#define LDSP __attribute__((address_space(3)))
typedef _Float16 h16;
typedef _Float16 h16x8 __attribute__((ext_vector_type(8)));
typedef _Float16 h16x4 __attribute__((ext_vector_type(4)));
typedef float f32x4 __attribute__((ext_vector_type(4)));
typedef unsigned u32x4 __attribute__((ext_vector_type(4)));

constexpr int S = 16384, D = 1024, FF = 4096, NIN = 4120;
constexpr int PP = 4096;
constexpr int C_QN = 0, C_KC = 512, C_VC = 640, C_KS = 768, C_VS = 896, C_KW = 1024, C_VW = 1152, C_QS = 1280, C_KSW = 1792, C_VSW = 1920, C_GA = 2048, C_GB = 3072;
constexpr int NCMP = 1023;
constexpr float EPS = 1e-6f;
constexpr int NWAVES = 8, NTHR = 512;
constexpr int LDS_BYTES = 147456;

constexpr size_t MiB = 1u << 20;
constexpr size_t WS_CTL = 0;
constexpr size_t WS_WIN = 1 * MiB;
constexpr size_t WS_W1 = 9 * MiB;
constexpr size_t WS_W2 = 17 * MiB;
constexpr size_t WS_WOUT = 25 * MiB;
constexpr size_t WS_WUA = 27 * MiB;
constexpr size_t WS_WUB = 28 * MiB;
constexpr size_t WS_CW1K = 29 * MiB;
constexpr size_t WS_CW1V = 30 * MiB;
constexpr size_t WS_SMALL = 31 * MiB;
constexpr size_t WS_WG = WS_SMALL, WS_CW2K = WS_SMALL + 65536, WS_CW2V = WS_CW2K + 32768, WS_CBP = WS_CW2V + 32768;
constexpr size_t WS_R1 = 32 * MiB;
constexpr size_t WS_OA = 64 * MiB;
constexpr size_t WS_OB = 80 * MiB;
constexpr size_t WS_Z2 = 32 * MiB;
constexpr size_t WS_R0 = 96 * MiB;
constexpr size_t WS_VST = 224 * MiB;
constexpr size_t WS_VWT = 228 * MiB;
constexpr size_t WS_VBT = 232 * MiB;
constexpr size_t WS_KC = 236 * MiB;
constexpr size_t WS_VCR = WS_KC + 262144;
constexpr size_t WS_VCT = WS_VCR + 262144;
constexpr size_t WS_RSTDX = 237 * MiB;
constexpr size_t WS_RSTD1 = WS_RSTDX + 65536;
constexpr size_t WS_IDX = 238 * MiB;

struct Args { const float* in[19]; float* out; unsigned char* ws; int ph_lo, ph_hi, coop, pad; };

__device__ __forceinline__ float wave_sum(float v) {
#pragma unroll
    for (int o = 32; o >= 1; o >>= 1) v += __shfl_xor(v, o);
    return v;
}
__device__ __forceinline__ float wave_max(float v) {
#pragma unroll
    for (int o = 32; o >= 1; o >>= 1) v = fmaxf(v, __shfl_xor(v, o));
    return v;
}
__device__ __forceinline__ void lds_wait() { asm volatile("s_waitcnt lgkmcnt(0)" ::: "memory"); }
__device__ __forceinline__ unsigned pkh(float a, float b) { h16 x = (h16)a, y = (h16)b; return (unsigned)__builtin_bit_cast(unsigned short, x) | ((unsigned)__builtin_bit_cast(unsigned short, y) << 16); }
__device__ __forceinline__ float sigmoidf_(float x) { return 1.0f / (1.0f + __expf(-x)); }

struct Ctx {
    LDSP unsigned char* lds; int tid, lane, wave, gw, NGW;
    const float* in[19]; float* out; unsigned char* ws;
};

__device__ __forceinline__ void transpose_item(const float* W, int ldw, int col0, const float* scale, int K, h16* WT, int item, int nblk, LDSP float* scr, int lane) {
    const int kb = item / nblk, nb = item % nblk, k0 = 64 * kb, n0 = 32 * nb;
#pragma unroll 8
    for (int i = 0; i < 32; ++i) { const int kk = 2 * i + (lane >> 5); float v = W[(size_t)(k0 + kk) * ldw + col0 + n0 + (lane & 31)]; if (scale) v *= scale[k0 + kk]; scr[kk * 33 + (lane & 31)] = v; }
    lds_wait();
    const int c = lane & 7;
#pragma unroll
    for (int j = 0; j < 4; ++j) { const int n = (lane >> 3) + 8 * j; const LDSP float* s = scr + (8 * c) * 33 + n;
        u32x4 o; o.x = pkh(s[0 * 33], s[1 * 33]); o.y = pkh(s[2 * 33], s[3 * 33]); o.z = pkh(s[4 * 33], s[5 * 33]); o.w = pkh(s[6 * 33], s[7 * 33]);
        *(u32x4*)(WT + (size_t)(n0 + n) * K + k0 + 8 * c) = o; }
    lds_wait();
}

__device__ __forceinline__ void phase_prologue(Ctx& C) {
    LDSP float* scr = (LDSP float*)(C.lds + C.wave * 16384);
    const float* w_in = C.in[5];
    constexpr int I_WIN_A = 16 * 40, I_WIN_B = 16 * 88, I_WG = 16, I_UP = 8 * 32, I_OUT = 16 * 32, I_W1 = 16 * 128, I_W2 = 64 * 32, I_C1 = 32 * 8, I_C2 = 4 * 2;
    constexpr int NITEMS = I_WIN_A + I_WIN_B + I_WG + 2 * I_UP + I_OUT + I_W1 + I_W2 + 2 * I_C1 + 2 * I_C2;
    for (int it = C.gw; it < NITEMS; it += C.NGW) {
        int r = it;
        if (r < I_WIN_A) { transpose_item(w_in, NIN, 0, C.in[1], D, (h16*)(C.ws + WS_WIN), r, 40, scr, C.lane); continue; } r -= I_WIN_A;
        if (r < I_WIN_B) { transpose_item(w_in, NIN, 1304, C.in[1], D, (h16*)(C.ws + WS_WIN) + (size_t)1280 * D, r, 88, scr, C.lane); continue; } r -= I_WIN_B;
        if (r < I_WG) { transpose_item(w_in, NIN, 1280, C.in[1], D, (h16*)(C.ws + WS_WG), r, 1, scr, C.lane); continue; } r -= I_WG;
        if (r < I_UP) { transpose_item(C.in[14], D, 0, nullptr, 512, (h16*)(C.ws + WS_WUA), r, 32, scr, C.lane); continue; } r -= I_UP;
        if (r < I_UP) { transpose_item(C.in[15], D, 0, nullptr, 512, (h16*)(C.ws + WS_WUB), r, 32, scr, C.lane); continue; } r -= I_UP;
        if (r < I_OUT) { transpose_item(C.in[16], D, 0, nullptr, D, (h16*)(C.ws + WS_WOUT), r, 32, scr, C.lane); continue; } r -= I_OUT;
        if (r < I_W1) { transpose_item(C.in[17], FF, 0, C.in[3], D, (h16*)(C.ws + WS_W1), r, 128, scr, C.lane); continue; } r -= I_W1;
        if (r < I_W2) { transpose_item(C.in[18], D, 0, nullptr, FF, (h16*)(C.ws + WS_W2), r, 32, scr, C.lane); continue; } r -= I_W2;
        if (r < I_C1) { transpose_item(C.in[7], 256, 0, nullptr, 2048, (h16*)(C.ws + WS_CW1K), r, 8, scr, C.lane); continue; } r -= I_C1;
        if (r < I_C1) { transpose_item(C.in[10], 256, 0, nullptr, 2048, (h16*)(C.ws + WS_CW1V), r, 8, scr, C.lane); continue; } r -= I_C1;
        if (r < I_C2) { transpose_item(C.in[8], 64, 0, nullptr, 256, (h16*)(C.ws + WS_CW2K), r, 2, scr, C.lane); continue; } r -= I_C2;
        transpose_item(C.in[11], 64, 0, nullptr, 256, (h16*)(C.ws + WS_CW2V), r, 2, scr, C.lane);
    }
    for (int u = C.gw; u < 16 * 2 * 4; u += C.NGW) {
        const int s = u >> 3, kv = (u >> 2) & 1, nb = u & 3, n = nb * 64 + C.lane;
        const float* pos = C.in[kv ? 9 : 6]; const float* w1 = C.in[kv ? 10 : 7];
        float acc = 0.f;
        for (int k = s * 128; k < s * 128 + 128; ++k) acc += pos[k] * w1[(size_t)k * 256 + n];
        ((float*)(C.ws + WS_CBP))[(s * 2 + kv) * 256 + n] = acc;
    }
    h16* xh = (h16*)(C.ws + WS_R1); float* rstdx = (float*)(C.ws + WS_RSTDX);
    for (int m = C.gw; m < S; m += C.NGW) {
        const f32x4* xr = (const f32x4*)(C.in[0] + (size_t)m * D) + C.lane;
        f32x4 v[4]; float s = 0.f;
#pragma unroll
        for (int j = 0; j < 4; ++j) { v[j] = xr[64 * j]; s += (v[j].x * v[j].x + v[j].y * v[j].y) + (v[j].z * v[j].z + v[j].w * v[j].w); }
        s = wave_sum(s);
        if (C.lane == 0) rstdx[m] = 1.0f / sqrtf(s * (1.0f / D) + EPS);
        unsigned long long* o8 = (unsigned long long*)(xh + (size_t)m * D) + C.lane;
#pragma unroll
        for (int j = 0; j < 4; ++j) o8[64 * j] = (unsigned long long)pkh(v[j].x, v[j].y) | ((unsigned long long)pkh(v[j].z, v[j].w) << 32);
    }
}

template <class Epi>
__device__ __forceinline__ void ngemm(const h16* A1, int lda1, const h16* B1, int K1, const h16* A2, int lda2, const h16* B2, int K2, int M, int N, const Epi& epi, int gw, int NGW, int lane) {
    const int tn_cnt = N / 32, tiles = (M / 32) * tn_cnt, fr = lane & 15, fq = lane >> 4;
    for (int tile = gw; tile < tiles; tile += NGW) {
        const int tm = tile / tn_cnt, tn = tile % tn_cnt;
        f32x4 acc1[2][2], acc2[2][2];
#pragma unroll
        for (int i = 0; i < 2; ++i)
#pragma unroll
            for (int j = 0; j < 2; ++j) { acc1[i][j] = (f32x4){0.f, 0.f, 0.f, 0.f}; acc2[i][j] = (f32x4){0.f, 0.f, 0.f, 0.f}; }
        {
            const h16* a = A1 + (size_t)(tm * 32 + fr) * lda1 + 8 * fq; const h16* b = B1 + (size_t)(tn * 32 + fr) * K1 + 8 * fq;
            for (int k = 0; k < K1; k += 32) {
                const h16x8 a0 = *(const h16x8*)(a + k), a1 = *(const h16x8*)(a + (size_t)16 * lda1 + k);
                const h16x8 b0 = *(const h16x8*)(b + k), b1 = *(const h16x8*)(b + (size_t)16 * K1 + k);
                acc1[0][0] = __builtin_amdgcn_mfma_f32_16x16x32_f16(a0, b0, acc1[0][0], 0, 0, 0);
                acc1[0][1] = __builtin_amdgcn_mfma_f32_16x16x32_f16(a0, b1, acc1[0][1], 0, 0, 0);
                acc1[1][0] = __builtin_amdgcn_mfma_f32_16x16x32_f16(a1, b0, acc1[1][0], 0, 0, 0);
                acc1[1][1] = __builtin_amdgcn_mfma_f32_16x16x32_f16(a1, b1, acc1[1][1], 0, 0, 0);
            }
        }
        if (K2 > 0) {
            const h16* a = A2 + (size_t)(tm * 32 + fr) * lda2 + 8 * fq; const h16* b = B2 + (size_t)(tn * 32 + fr) * K2 + 8 * fq;
            for (int k = 0; k < K2; k += 32) {
                const h16x8 a0 = *(const h16x8*)(a + k), a1 = *(const h16x8*)(a + (size_t)16 * lda2 + k);
                const h16x8 b0 = *(const h16x8*)(b + k), b1 = *(const h16x8*)(b + (size_t)16 * K2 + k);
                acc2[0][0] = __builtin_amdgcn_mfma_f32_16x16x32_f16(a0, b0, acc2[0][0], 0, 0, 0);
                acc2[0][1] = __builtin_amdgcn_mfma_f32_16x16x32_f16(a0, b1, acc2[0][1], 0, 0, 0);
                acc2[1][0] = __builtin_amdgcn_mfma_f32_16x16x32_f16(a1, b0, acc2[1][0], 0, 0, 0);
                acc2[1][1] = __builtin_amdgcn_mfma_f32_16x16x32_f16(a1, b1, acc2[1][1], 0, 0, 0);
            }
        }
#pragma unroll
        for (int i = 0; i < 2; ++i)
#pragma unroll
            for (int j = 0; j < 2; ++j)
#pragma unroll
                for (int r = 0; r < 4; ++r) epi(tm * 32 + 16 * i + 4 * fq + r, tn * 32 + 16 * j + fr, acc1[i][j][r], acc2[i][j][r]);
    }
}

struct EpiProj {
    h16* proj; const float* rstd; h16* vsT; h16* vwT; h16* vbT;
    __device__ __forceinline__ void operator()(int row, int col, float v, float) const {
        const h16 o = (h16)(v * rstd[row]);
        proj[(size_t)row * PP + col] = o;
        if (col >= C_VS && col < C_VS + 128) vsT[(size_t)(col - C_VS) * S + row] = o;
        else if (col >= C_VW && col < C_VW + 128) vwT[(size_t)(col - C_VW) * S + row] = o;
        else if (col >= C_VSW && col < C_VSW + 128) vbT[(size_t)(col - C_VSW) * S + row] = o;
    }
};
struct EpiUp {
    h16* y; const h16* proj;
    __device__ __forceinline__ void operator()(int row, int col, float v1, float v2) const {
        const float ga = (float)proj[(size_t)row * PP + C_GA + col], gb = (float)proj[(size_t)row * PP + C_GB + col];
        y[(size_t)row * D + col] = (h16)(sigmoidf_(ga) * v1 + sigmoidf_(gb) * v2);
    }
};
struct EpiF32 { float* z; int ldz;
    __device__ __forceinline__ void operator()(int row, int col, float v, float) const { z[(size_t)row * ldz + col] = v; } };
struct EpiRelu2 { h16* a; const float* rstd;
    __device__ __forceinline__ void operator()(int row, int col, float v, float) const { float u = fmaxf(v * rstd[row], 0.f); a[(size_t)row * FF + col] = (h16)(u * u); } };

__device__ __forceinline__ float gelu_tanh(float x) { const float u = 0.7978845608028654f * (x + 0.044715f * x * x * x); return 0.5f * x * (1.0f + tanhf(u)); }
__device__ __forceinline__ void phase_compress_naive(Ctx& C) {
    LDSP float* hs = (LDSP float*)(C.lds + C.wave * 2048);
    const h16* proj = (const h16*)(C.ws + WS_R0);
    const float* cbp = (const float*)(C.ws + WS_CBP);
    for (int u = C.gw; u < 2 * NCMP * 2; u += C.NGW) {
        const int kv = u / (NCMP * 2), rem = u % (NCMP * 2), i = rem >> 1, g = rem & 1;
        const h16* w1T = (const h16*)(C.ws + (kv ? WS_CW1V : WS_CW1K)); const h16* w2T = (const h16*)(C.ws + (kv ? WS_CW2V : WS_CW2K));
        const int col = (kv ? C_VC : C_KC) + g * 64;
        float acc[4];
#pragma unroll
        for (int m = 0; m < 4; ++m) { float b = 0.f; for (int s = 0; s < 16; ++s) b += cbp[(s * 2 + kv) * 256 + C.lane + 64 * m]; acc[m] = b; }
        for (int j = 0; j < 32; ++j) {
            const h16* xr = proj + (size_t)(16 * i + j) * PP + col;
#pragma unroll
            for (int c = 0; c < 8; ++c) {
                const h16x8 xv = *(const h16x8*)(xr + 8 * c);
#pragma unroll
                for (int m = 0; m < 4; ++m) { const h16x8 wv = *(const h16x8*)(w1T + (size_t)(C.lane + 64 * m) * 2048 + j * 64 + 8 * c);
#pragma unroll
                    for (int e = 0; e < 8; ++e) acc[m] += (float)xv[e] * (float)wv[e]; }
            }
        }
#pragma unroll
        for (int m = 0; m < 4; ++m) hs[C.lane + 64 * m] = gelu_tanh(acc[m]);
        lds_wait();
        float o = 0.f;
        for (int n = 0; n < 256; n += 8) { const h16x8 wv = *(const h16x8*)(w2T + (size_t)C.lane * 256 + n);
#pragma unroll
            for (int e = 0; e < 8; ++e) o += hs[n + e] * (float)wv[e]; }
        lds_wait();
        if (kv == 0) ((h16*)(C.ws + WS_KC))[((size_t)i * 2 + g) * 64 + C.lane] = (h16)o;
        else { ((h16*)(C.ws + WS_VCR))[((size_t)i * 2 + g) * 64 + C.lane] = (h16)o; ((h16*)(C.ws + WS_VCT))[((size_t)g * 64 + C.lane) * 1024 + i] = (h16)o; }
    }
}

__device__ __forceinline__ void build_bucket_table(Ctx& C, LDSP unsigned char* buck) {
    for (int d = C.tid; d < 1024; d += NTHR) {
        int b;
        if (d < 16) b = d;
        else { const float x = (float)d / 16.0f; int l = 16 + (int)(logf(x) / 4.158883083359672f * 16.0f); b = l < 31 ? l : 31; }
        buck[d] = (unsigned char)b;
    }
    __syncthreads();
}

template <int MODE, int NB>
__device__ __forceinline__ void nattn(Ctx& C, int t, int g, LDSP float* scr, const LDSP unsigned char* buck, float (&o)[4]) {
    LDSP float* qs = scr; LDSP float* sc = scr + 256;
    const h16* proj = (const h16*)(C.ws + WS_R0);
    const int lane = C.lane;
    { const h16x4 qv = *(const h16x4*)(proj + (size_t)t * PP + (MODE == 3 ? C_QS : C_QN) + g * 256 + lane * 4);
#pragma unroll
      for (int e = 0; e < 4; ++e) qs[lane * 4 + e] = (float)qv[e]; }
    lds_wait();
    const int cur = t >> 6;
    const int nvalid = (t >= 31) ? (((t - 31) >> 4) + 1) : 0;
    const int nsel = (cur + 1) < 16 ? (cur + 1) : 16;
    const unsigned char* idxp = (const unsigned char*)(C.ws + WS_IDX) + ((size_t)t * 2 + g) * 16;
    const float* relb = C.in[13] + (MODE == 3 ? 8 : 0) + g * 4;
    const int kcol = (MODE == 1 ? C_KS : MODE == 2 ? C_KW : C_KSW) + g * 64;
    const int vcol = (MODE == 1 ? C_VS : MODE == 2 ? C_VW : C_VSW) + g * 64;
    const int nb = (MODE == 1) ? nsel : NB;
    float mx[4] = {-INFINITY, -INFINITY, -INFINITY, -INFINITY};
#pragma unroll 1
    for (int b = 0; b < nb; ++b) {
        int pos = 0; bool valid; const h16* krow;
        if (MODE == 0) { const int n = b * 64 + lane; valid = n < nvalid; krow = (const h16*)(C.ws + WS_KC) + ((size_t)(n < 1022 ? n : 1022) * 2 + g) * 64; }
        else {
            if (MODE == 1) { const int bid = (int)idxp[b]; pos = bid * 64 + lane; valid = (pos <= t); }
            else if (MODE == 2) { pos = t - 511 + 64 * b + lane; valid = pos >= 0; }
            else { pos = t - 127 + 64 * b + lane; valid = pos >= 0; }
            const int pc = pos < 0 ? 0 : pos;
            krow = proj + (size_t)pc * PP + kcol;
        }
        float a0 = 0.f, a1 = 0.f, a2 = 0.f, a3 = 0.f;
#pragma unroll 2
        for (int c = 0; c < 8; ++c) { const h16x8 kv = *(const h16x8*)(krow + 8 * c);
#pragma unroll
            for (int e = 0; e < 8; ++e) { const float kf = (float)kv[e]; a0 += qs[8 * c + e] * kf; a1 += qs[64 + 8 * c + e] * kf; a2 += qs[128 + 8 * c + e] * kf; a3 += qs[192 + 8 * c + e] * kf; } }
        float b0 = 0.f, b1 = 0.f, b2 = 0.f, b3 = 0.f;
        if (MODE != 0) { int dist = t - pos; dist = dist < 0 ? 0 : (dist > 1023 ? 1023 : dist); const int bk = buck[dist]; b0 = relb[bk * 16 + 0]; b1 = relb[bk * 16 + 1]; b2 = relb[bk * 16 + 2]; b3 = relb[bk * 16 + 3]; }
        a0 = valid ? a0 * 0.125f + b0 : -INFINITY; a1 = valid ? a1 * 0.125f + b1 : -INFINITY;
        a2 = valid ? a2 * 0.125f + b2 : -INFINITY; a3 = valid ? a3 * 0.125f + b3 : -INFINITY;
        sc[b * 64 + lane] = a0; sc[1024 + b * 64 + lane] = a1; sc[2048 + b * 64 + lane] = a2; sc[3072 + b * 64 + lane] = a3;
        mx[0] = fmaxf(mx[0], a0); mx[1] = fmaxf(mx[1], a1); mx[2] = fmaxf(mx[2], a2); mx[3] = fmaxf(mx[3], a3);
    }
    float inv[4];
#pragma unroll
    for (int h = 0; h < 4; ++h) {
        float m = wave_max(mx[h]);
        float sk = 0.f;
        if (MODE == 3) { sk = C.in[12][g * 4 + h]; m = fmaxf(m, sk); }
        const float ms = (m == -INFINITY) ? 0.f : m;
        float l = 0.f;
#pragma unroll 1
        for (int b = 0; b < nb; ++b) { const float e = __expf(sc[h * 1024 + b * 64 + lane] - ms); sc[h * 1024 + b * 64 + lane] = e; l += e; }
        l = wave_sum(l);
        if (MODE == 3) l += __expf(sk - ms);
        inv[h] = 1.0f / fmaxf(l, 1e-30f);
    }
    lds_wait();
    if (MODE == 0) {
        float scv[4];
#pragma unroll
        for (int c = 0; c < 4; ++c) { const int j = lane + 64 * c; float v = 0.f;
#pragma unroll 1
            for (int oo = 0; oo < 5; ++oo) { const int n = 4 * j + oo - 1; if (n >= 0 && n < NCMP) v += (sc[n] * inv[0] + sc[1024 + n] * inv[1]) + (sc[2048 + n] * inv[2] + sc[3072 + n] * inv[3]); }
            const bool val = j <= cur, forced = (j == 0) || (j == cur) || (j == cur - 1);
            scv[c] = val ? (forced ? INFINITY : v) : -INFINITY; }
        unsigned char* idxw = (unsigned char*)(C.ws + WS_IDX) + ((size_t)t * 2 + g) * 16;
#pragma unroll 1
        for (int it = 0; it < 16; ++it) {
            float bv = scv[0]; int bj = lane;
#pragma unroll
            for (int c = 1; c < 4; ++c) if (scv[c] > bv) { bv = scv[c]; bj = lane + 64 * c; }
#pragma unroll
            for (int of = 32; of >= 1; of >>= 1) { const float ov = __shfl_xor(bv, of); const int oj = __shfl_xor(bj, of); if (ov > bv || (ov == bv && oj < bj)) { bv = ov; bj = oj; } }
            if (bv == -INFINITY) bj = 0;
            if (lane == 0) idxw[it] = (unsigned char)bj;
#pragma unroll
            for (int c = 0; c < 4; ++c) if (bj == lane + 64 * c) scv[c] = -INFINITY;
        }
    }
    float x0 = 0.f, x1 = 0.f, x2 = 0.f, x3 = 0.f;
    if (MODE == 0) {
        const h16* V = (const h16*)(C.ws + WS_VCR) + g * 64 + lane;
#pragma unroll 2
        for (int n = 0; n < nvalid; ++n) { const float v = (float)V[(size_t)n * 128]; x0 += sc[n] * v; x1 += sc[1024 + n] * v; x2 += sc[2048 + n] * v; x3 += sc[3072 + n] * v; }
    } else {
#pragma unroll 1
        for (int b = 0; b < nb; ++b) {
            const int p0 = (MODE == 1) ? (int)idxp[b] * 64 : (MODE == 2 ? t - 511 + 64 * b : t - 127 + 64 * b);
#pragma unroll 2
            for (int i = 0; i < 64; ++i) { int pos = p0 + i; pos = pos < 0 ? 0 : (pos > S - 1 ? S - 1 : pos);
                const float v = (float)proj[(size_t)pos * PP + vcol + lane]; const int k = b * 64 + i;
                x0 += sc[k] * v; x1 += sc[1024 + k] * v; x2 += sc[2048 + k] * v; x3 += sc[3072 + k] * v; }
        }
    }
    o[0] = x0 * inv[0]; o[1] = x1 * inv[1]; o[2] = x2 * inv[2]; o[3] = x3 * inv[3];
    lds_wait();
}

__device__ __forceinline__ void phase_cmp_swa_naive(Ctx& C) {
    LDSP unsigned char* buck = C.lds; LDSP float* scr = (LDSP float*)(C.lds + 1024 + C.wave * 17408);
    build_bucket_table(C, buck);
    h16* oa = (h16*)(C.ws + WS_OA); h16* ob = (h16*)(C.ws + WS_OB);
    for (int u = C.gw; u < 2 * S * 2; u += C.NGW) {
        const int which = u / (S * 2), r = u % (S * 2), t = r >> 1, g = r & 1; float o[4];
        if (which == 0) { nattn<0, 16>(C, t, g, scr, buck, o);
#pragma unroll
            for (int h = 0; h < 4; ++h) oa[(size_t)t * 512 + (g * 4 + h) * 64 + C.lane] = (h16)o[h]; }
        else { nattn<3, 2>(C, t, g, scr, buck, o);
#pragma unroll
            for (int h = 0; h < 4; ++h) ob[(size_t)t * 512 + (g * 4 + h) * 64 + C.lane] = (h16)o[h]; }
    }
}
__device__ __forceinline__ void phase_selwin_naive(Ctx& C) {
    LDSP unsigned char* buck = C.lds; LDSP float* scr = (LDSP float*)(C.lds + 1024 + C.wave * 17408);
    build_bucket_table(C, buck);
    h16* oa = (h16*)(C.ws + WS_OA);
    const h16* xh = (const h16*)(C.ws + WS_R1); const h16* WgT = (const h16*)(C.ws + WS_WG); const float* rstdx = (const float*)(C.ws + WS_RSTDX);
    for (int u = C.gw; u < S * 2; u += C.NGW) {
        const int t = u >> 1, g = u & 1; float os[4], ow[4];
        nattn<1, 16>(C, t, g, scr, buck, os);
        nattn<2, 8>(C, t, g, scr, buck, ow);
        const h16x8 x0 = *(const h16x8*)(xh + (size_t)t * D + C.lane * 16), x1 = *(const h16x8*)(xh + (size_t)t * D + C.lane * 16 + 8);
        float gt[12]; const float rs = rstdx[t];
#pragma unroll
        for (int c = 0; c < 12; ++c) { const h16* wr = WgT + (size_t)(g * 12 + c) * D + C.lane * 16; const h16x8 w0 = *(const h16x8*)wr, w1 = *(const h16x8*)(wr + 8); float a = 0.f;
#pragma unroll
            for (int e = 0; e < 8; ++e) a += (float)x0[e] * (float)w0[e] + (float)x1[e] * (float)w1[e];
            gt[c] = sigmoidf_(wave_sum(a) * rs); }
#pragma unroll
        for (int h = 0; h < 4; ++h) { h16* p = oa + (size_t)t * 512 + (g * 4 + h) * 64 + C.lane; const float oc = (float)*p;
            *p = (h16)(gt[h * 3 + 0] * oc + gt[h * 3 + 1] * os[h] + gt[h * 3 + 2] * ow[h]); }
    }
}

__device__ __forceinline__ void phase_rows1(Ctx& C) {
    const float* z = (const float*)(C.ws + WS_R0); h16* h1h = (h16*)(C.ws + WS_R1); float* rstd1 = (float*)(C.ws + WS_RSTD1);
    for (int m = C.gw; m < S; m += C.NGW) {
        const f32x4* zr = (const f32x4*)(z + (size_t)m * D) + C.lane; const f32x4* xr = (const f32x4*)(C.in[0] + (size_t)m * D) + C.lane; const f32x4* gr = (const f32x4*)C.in[2] + C.lane;
        f32x4 v[4]; float s = 0.f;
#pragma unroll
        for (int j = 0; j < 4; ++j) { v[j] = zr[64 * j]; s += (v[j].x * v[j].x + v[j].y * v[j].y) + (v[j].z * v[j].z + v[j].w * v[j].w); }
        const float rs = 1.0f / sqrtf(wave_sum(s) * (1.0f / D) + EPS); float s2 = 0.f;
#pragma unroll
        for (int j = 0; j < 4; ++j) { v[j] = xr[64 * j] + v[j] * rs * gr[64 * j]; s2 += (v[j].x * v[j].x + v[j].y * v[j].y) + (v[j].z * v[j].z + v[j].w * v[j].w); }
        s2 = wave_sum(s2);
        if (C.lane == 0) rstd1[m] = 1.0f / sqrtf(s2 * (1.0f / D) + EPS);
        f32x4* orow = (f32x4*)(C.out + (size_t)m * D) + C.lane; unsigned long long* o8 = (unsigned long long*)(h1h + (size_t)m * D) + C.lane;
#pragma unroll
        for (int j = 0; j < 4; ++j) { orow[64 * j] = v[j]; o8[64 * j] = (unsigned long long)pkh(v[j].x, v[j].y) | ((unsigned long long)pkh(v[j].z, v[j].w) << 32); }
    }
}
__device__ __forceinline__ void phase_rows2(Ctx& C) {
    const float* z = (const float*)(C.ws + WS_Z2);
    for (int m = C.gw; m < S; m += C.NGW) {
        const f32x4* zr = (const f32x4*)(z + (size_t)m * D) + C.lane; f32x4* orow = (f32x4*)(C.out + (size_t)m * D) + C.lane; const f32x4* gr = (const f32x4*)C.in[4] + C.lane;
        f32x4 v[4]; float s = 0.f;
#pragma unroll
        for (int j = 0; j < 4; ++j) { v[j] = zr[64 * j]; s += (v[j].x * v[j].x + v[j].y * v[j].y) + (v[j].z * v[j].z + v[j].w * v[j].w); }
        const float rs = 1.0f / sqrtf(wave_sum(s) * (1.0f / D) + EPS);
#pragma unroll
        for (int j = 0; j < 4; ++j) orow[64 * j] = orow[64 * j] + v[j] * rs * gr[64 * j];
    }
}

constexpr int NPHASE = 11;
__global__ void __launch_bounds__(NTHR, 2) fwd_kernel(Args args) {
    extern __shared__ __attribute__((aligned(16))) unsigned char lds_raw[];
    Ctx C;
    C.lds = (LDSP unsigned char*)lds_raw; C.tid = threadIdx.x; C.lane = C.tid & 63; C.wave = __builtin_amdgcn_readfirstlane(C.tid >> 6);
    C.gw = blockIdx.x * NWAVES + C.wave; C.NGW = gridDim.x * NWAVES;
#pragma unroll
    for (int i = 0; i < 19; ++i) C.in[i] = args.in[i];
    C.out = args.out; C.ws = args.ws;
    const int lo = args.ph_lo, hi = args.ph_hi;
    unsigned char* ws = args.ws;
#define IN(k) (lo <= (k) && (k) < hi)
#define SEAM(k) do { if (IN(k) && IN((k) + 1)) { if (args.coop) { cg::this_grid().sync(); } } } while (0)
    if (IN(0)) { phase_prologue(C); } SEAM(0);
    if (IN(1)) { EpiProj E{(h16*)(ws + WS_R0), (const float*)(ws + WS_RSTDX), (h16*)(ws + WS_VST), (h16*)(ws + WS_VWT), (h16*)(ws + WS_VBT)};
        ngemm((const h16*)(ws + WS_R1), D, (const h16*)(ws + WS_WIN), D, nullptr, 0, nullptr, 0, S, PP, E, C.gw, C.NGW, C.lane); } SEAM(1);
    if (IN(2)) { phase_compress_naive(C); } SEAM(2);
    if (IN(3)) { __syncthreads(); phase_cmp_swa_naive(C); } SEAM(3);
    if (IN(4)) { __syncthreads(); phase_selwin_naive(C); } SEAM(4);
    if (IN(5)) { EpiUp E{(h16*)(ws + WS_R1), (const h16*)(ws + WS_R0)};
        ngemm((const h16*)(ws + WS_OA), 512, (const h16*)(ws + WS_WUA), 512, (const h16*)(ws + WS_OB), 512, (const h16*)(ws + WS_WUB), 512, S, D, E, C.gw, C.NGW, C.lane); } SEAM(5);
    if (IN(6)) { EpiF32 E{(float*)(ws + WS_R0), D};
        ngemm((const h16*)(ws + WS_R1), D, (const h16*)(ws + WS_WOUT), D, nullptr, 0, nullptr, 0, S, D, E, C.gw, C.NGW, C.lane); } SEAM(6);
    if (IN(7)) { phase_rows1(C); } SEAM(7);
    if (IN(8)) { EpiRelu2 E{(h16*)(ws + WS_R0), (const float*)(ws + WS_RSTD1)};
        ngemm((const h16*)(ws + WS_R1), D, (const h16*)(ws + WS_W1), D, nullptr, 0, nullptr, 0, S, FF, E, C.gw, C.NGW, C.lane); } SEAM(8);
    if (IN(9)) { EpiF32 E{(float*)(ws + WS_Z2), D};
        ngemm((const h16*)(ws + WS_R0), FF, (const h16*)(ws + WS_W2), FF, nullptr, 0, nullptr, 0, S, D, E, C.gw, C.NGW, C.lane); } SEAM(9);
    if (IN(10)) { phase_rows2(C); }
#undef IN
#undef SEAM
}

extern "C" void kernel_launch(void* const* d_in, const int* in_sizes, int n_in, void* d_out, int out_size, void* d_ws, size_t ws_size, hipStream_t stream) {
    static int grid = 0;
    if (grid == 0) {
        int dev = 0, cus = 0, per_cu = 0;
        hipGetDevice(&dev);
        hipDeviceGetAttribute(&cus, hipDeviceAttributeMultiprocessorCount, dev);
        hipFuncSetAttribute((const void*)fwd_kernel, hipFuncAttributeMaxDynamicSharedMemorySize, LDS_BYTES);
        hipOccupancyMaxActiveBlocksPerMultiprocessor(&per_cu, (const void*)fwd_kernel, NTHR, LDS_BYTES);
        if (per_cu < 1) { fprintf(stderr, "occupancy query says %d blocks/CU\n", per_cu); per_cu = 1; }
        grid = cus * 1;
        (void)hipGetLastError();
    }
    Args a{};
    for (int i = 0; i < 19; ++i) a.in[i] = (const float*)d_in[i];
    a.out = (float*)d_out; a.ws = (unsigned char*)d_ws;
#if N_LAUNCH_MODE == 1
    a.ph_lo = 0; a.ph_hi = NPHASE; a.coop = 1;
    void* kargs[] = {&a};
    hipError_t e = hipLaunchCooperativeKernel((const void*)fwd_kernel, dim3(grid), dim3(NTHR), kargs, LDS_BYTES, stream);
    if (e != hipSuccess) fprintf(stderr, "cooperative launch failed: %s (grid %d)\n", hipGetErrorString(e), grid);
#else
    for (int p = 0; p < NPHASE; ++p) {
        a.ph_lo = p; a.ph_hi = p + 1; a.coop = 0;
        hipLaunchKernelGGL(fwd_kernel, dim3(grid), dim3(NTHR), LDS_BYTES, stream, a);
    }
#endif
}
```

```cpp
#include <hip/hip_runtime.h>
#include <hip/hip_cooperative_groups.h>
#include <cstdio>
#include <cstdint>
namespace cg = cooperative_groups;

#ifndef USE_MFMA_P3
#define USE_MFMA_P3 1
#endif
#ifndef USE_MFMA_CMP
#define USE_MFMA_CMP 1
#endif
#ifndef USE_MFMA_SWA
#define USE_MFMA_SWA 1
#endif
#ifndef USE_MFMA_P4
#define USE_MFMA_P4 1
#endif
#ifndef N_LAUNCH_MODE
#define N_LAUNCH_MODE 1
#endif

#define LDSP __attribute__((address_space(3)))
typedef _Float16 h16;
typedef _Float16 h16x8 __attribute__((ext_vector_type(8)));
typedef _Float16 h16x4 __attribute__((ext_vector_type(4)));
typedef float f32x4 __attribute__((ext_vector_type(4)));
typedef unsigned u32x4 __attribute__((ext_vector_type(4)));

constexpr int S = 16384, D = 1024, FF = 4096, NIN = 4120;
constexpr int PP = 4096;
constexpr int C_QN = 0, C_KC = 512, C_VC = 640, C_KS = 768, C_VS = 896, C_KW = 1024, C_VW = 1152, C_QS = 1280, C_KSW = 1792, C_VSW = 1920, C_GA = 2048, C_GB = 3072;
constexpr int NCMP = 1023;
constexpr float EPS = 1e-6f;
constexpr int NWAVES = 8, NTHR = 512;
constexpr int LDS_BYTES = 163840;

constexpr size_t MiB = 1u << 20;
constexpr size_t WS_CTL = 0;
constexpr size_t WS_WIN = 1 * MiB;
constexpr size_t WS_W1 = 9 * MiB;
constexpr size_t WS_W2 = 17 * MiB;
constexpr size_t WS_WOUT = 25 * MiB;
constexpr size_t WS_WUA = 27 * MiB;
constexpr size_t WS_WUB = 28 * MiB;
constexpr size_t WS_CW1K = 29 * MiB;
constexpr size_t WS_CW1V = 30 * MiB;
constexpr size_t WS_SMALL = 31 * MiB;
constexpr size_t WS_WG = WS_SMALL, WS_CW2K = WS_SMALL + 65536, WS_CW2V = WS_CW2K + 32768, WS_CBP = WS_CW2V + 32768;
constexpr size_t WS_R1 = 32 * MiB;
constexpr size_t WS_OA = 64 * MiB;
constexpr size_t WS_OB = 80 * MiB;
constexpr size_t WS_Z2 = 32 * MiB;
constexpr size_t WS_R0 = 96 * MiB;
constexpr size_t WS_VST = 224 * MiB;
constexpr size_t WS_VWT = 228 * MiB;
constexpr size_t WS_VBT = 232 * MiB;
constexpr size_t WS_KC = 236 * MiB;
constexpr size_t WS_VCR = WS_KC + 262144;
constexpr size_t WS_VCT = WS_VCR + 262144;
constexpr size_t WS_RSTDX = 237 * MiB;
constexpr size_t WS_RSTD1 = WS_RSTDX + 65536;
constexpr size_t WS_IDX = 238 * MiB;
constexpr size_t WS_GS = 238 * MiB + 524288;
constexpr size_t WS_OW = 240 * MiB;

struct Args { const float* in[19]; float* out; unsigned char* ws; int ph_lo, ph_hi, coop, pad; };

__device__ __forceinline__ float wave_sum(float v) {
#pragma unroll
    for (int o = 32; o >= 1; o >>= 1) v += __shfl_xor(v, o);
    return v;
}
__device__ __forceinline__ float wave_max(float v) {
#pragma unroll
    for (int o = 32; o >= 1; o >>= 1) v = fmaxf(v, __shfl_xor(v, o));
    return v;
}
__device__ __forceinline__ void lds_wait() { asm volatile("s_waitcnt lgkmcnt(0)" ::: "memory"); }
__device__ __forceinline__ unsigned pkh(float a, float b) { h16 x = (h16)a, y = (h16)b; return (unsigned)__builtin_bit_cast(unsigned short, x) | ((unsigned)__builtin_bit_cast(unsigned short, y) << 16); }
__device__ __forceinline__ float sigmoidf_(float x) { return 1.0f / (1.0f + __expf(-x)); }

struct Ctx {
    LDSP unsigned char* lds; int tid, lane, wave, gw, NGW;
    const float* in[19]; float* out; unsigned char* ws;
};

namespace pg8 {
#define PG8_LAS __attribute__((address_space(3)))
typedef _Float16 bf16_t;
typedef _Float16 bf16x8 __attribute__((ext_vector_type(8)));
typedef float f32x4 __attribute__((ext_vector_type(4)));
typedef unsigned u32x4 __attribute__((ext_vector_type(4)));
constexpr int BM = 256, BK = 64, HALF = 128, HTB = HALF * BK * 2  , STAGE_BYTES = 8 * HTB, NXCD = 8, WGM = 8;

__host__ __device__ __forceinline__ int lds_byte(int r, int c) { const int st = (r >> 4) * 2 + (c >> 5), rr = r & 15, cc = c & 31, ob = rr * 64 + cc * 2; return st * 1024 + (ob ^ (((ob >> 9) & 1) << 5)); }
__host__ __device__ __forceinline__ void stage_rc(int b, int& R, int& C) { const int st = b / 1024, sb = b % 1024, swz = sb ^ (((sb >> 9) & 1) << 5); R = (st >> 1) * 16 + swz / 64; C = (st & 1) * 32 + (swz % 64) / 2; }
__host__ __device__ __forceinline__ int perm32(int rho) { const int n = rho >> 4, i = rho & 15; return 8 * (i >> 2) + 4 * n + (i & 3); }

struct Unit { int pm, pn; };
struct Gemm { const bf16_t* A; const bf16_t* Bt; int M, N, K; };

struct StaticOrder {
    int nM, nN, nwg, G, c;
    __host__ __device__ void init(int M, int N, int G_, int c_) { nM = M / BM; nN = N / BM; nwg = nM * nN; G = G_; c = c_; }
    __host__ __device__ bool next(int i, Unit& u) const {
        const long L = (long)i * G + c; if (L >= nwg) return false;
        int wgid = (int)L; { const int q = nwg / NXCD, r = nwg % NXCD, xcd = wgid % NXCD, off = wgid / NXCD; wgid = (xcd < r ? xcd * (q + 1) : r * (q + 1) + (xcd - r) * q) + off; }
        const int nig = WGM * nN, gid = wgid / nig, fm = gid * WGM, gsz = (nM - fm) < WGM ? (nM - fm) : WGM;
        u.pm = fm + ((wgid % nig) % gsz); u.pn = (wgid % nig) / gsz; return true;
    }
    __device__ __forceinline__ void a_ready(const Unit&) const {}
    __device__ __forceinline__ void done(const Unit&) const {}
};
template <class Epi, class Sched, bool ALIGN_EPI = false, bool SP2 = false>
__device__ __forceinline__ void gemm_phase(PG8_LAS unsigned char* lds, const Gemm g, const Sched& S, const Epi& E) {
    const int tid = threadIdx.x, wid = __builtin_amdgcn_readfirstlane(tid >> 6), lane = tid & 63, wr = wid >> 2, wc = wid & 3, fr = lane & 15, fq = lane >> 4;
    const int K = g.K, nt = K / BK;
    unsigned voffA[2], voffB[2];
#pragma unroll
    for (int i = 0; i < 2; ++i) { int R, C; stage_rc(tid * 16 + i * 8192, R, C); const int Rb = Epi::PERM ? ((R & ~31) + perm32(R & 31)) : R;
        voffA[i] = (unsigned)(R * K + C) * 2u; voffB[i] = (unsigned)(Rb * K + C) * 2u; }
    const size_t kstep = (size_t)(BK * 2);
    const size_t hstep = (size_t)HALF * K * 2;
    const size_t tstep = 2 * hstep;
    const unsigned ldsw = (unsigned)wid * 1024u;
    const int aoff = lds_byte(wr * 64 + fr, fq * 8), boff = lds_byte(wc * 32 + fr, fq * 8);
#define PG8_SA(b, h) (((b) * 2 + (h)) * HTB)
#define PG8_SB(b, h) ((4 + (b) * 2 + (h)) * HTB)
#define PG8_STAGE(bufoff, gbase, voff) do { _Pragma("unroll") for (int _i = 0; _i < 2; ++_i) \
        __builtin_amdgcn_global_load_lds((const unsigned*)((const char*)(gbase) + (voff)[_i]), (PG8_LAS unsigned*)(lds + (bufoff) + ldsw + _i * 8192), 16, 0, 0); } while (0)
#define PG8_LDA(dst, b, h) do { _Pragma("unroll") for (int m = 0; m < 4; ++m) _Pragma("unroll") for (int k = 0; k < 2; ++k) dst[m][k] = *(const PG8_LAS bf16x8*)(lds + PG8_SA(b, h) + aoff + m * 2048 + k * 1024); } while (0)
#define PG8_LDB(dst, b, h) do { _Pragma("unroll") for (int n = 0; n < 2; ++n) _Pragma("unroll") for (int k = 0; k < 2; ++k) dst[n][k] = *(const PG8_LAS bf16x8*)(lds + PG8_SB(b, h) + boff + n * 2048 + k * 1024); } while (0)
#define PG8_MMA(ai, bj, At, Bt) do { __builtin_amdgcn_s_setprio(1); _Pragma("unroll") for (int m = 0; m < 4; ++m) _Pragma("unroll") for (int n = 0; n < 2; ++n) _Pragma("unroll") for (int k = 0; k < 2; ++k) \
        acc[ai][bj][m][n] = __builtin_amdgcn_mfma_f32_16x16x32_f16(Bt[n][k], At[m][k], acc[ai][bj][m][n], 0, 0, 0); __builtin_amdgcn_s_setprio(0); } while (0)
#define PG8_WAIT_V(n) asm volatile("s_waitcnt vmcnt(" #n ")" ::: "memory")
#define PG8_WAIT_L(n) asm volatile("s_waitcnt lgkmcnt(" #n ")" ::: "memory")
#define PG8_BAR __builtin_amdgcn_s_barrier()
#define PG8_SCHED __builtin_amdgcn_sched_barrier(0)
    Unit cur, nxt; int ui = 0;
    if (!S.next(0, cur)) return;
    f32x4 acc[2][2][4][2];
#pragma unroll
    for (int a = 0; a < 2; ++a)
#pragma unroll
        for (int b = 0; b < 2; ++b)
#pragma unroll
            for (int m = 0; m < 4; ++m)
#pragma unroll
                for (int n = 0; n < 2; ++n) acc[a][b][m][n] = (f32x4){0.f, 0.f, 0.f, 0.f};
    bf16x8 At[4][2], B0[2][2], B1[2][2];
    const char* cA = (const char*)g.A + (size_t)cur.pm * tstep; const char* cB = (const char*)g.Bt + (size_t)cur.pn * tstep;
    S.a_ready(cur);
    if constexpr (SP2) {
        PG8_STAGE(PG8_SB(0, 0), cB, voffB); PG8_STAGE(PG8_SB(0, 1), cB + hstep, voffB); PG8_STAGE(PG8_SA(0, 0), cA, voffA); PG8_STAGE(PG8_SA(0, 1), cA + hstep, voffA);
        if (wr == 1) PG8_BAR;
        PG8_WAIT_V(2); PG8_BAR;
        PG8_STAGE(PG8_SB(1, 0), cB + kstep, voffB); PG8_STAGE(PG8_SA(1, 0), cA + kstep, voffA); PG8_STAGE(PG8_SB(1, 1), cB + hstep + kstep, voffB);
        PG8_WAIT_V(6); PG8_BAR;
    } else {
        PG8_STAGE(PG8_SB(0, 0), cB, voffB); PG8_STAGE(PG8_SA(0, 0), cA, voffA); PG8_STAGE(PG8_SB(0, 1), cB + hstep, voffB); PG8_STAGE(PG8_SA(0, 1), cA + hstep, voffA);
        if (wr == 1) PG8_BAR;
        PG8_WAIT_V(4); PG8_BAR;
        PG8_STAGE(PG8_SB(1, 0), cB + kstep, voffB); PG8_STAGE(PG8_SA(1, 0), cA + kstep, voffA); PG8_STAGE(PG8_SB(1, 1), cB + hstep + kstep, voffB);
        PG8_WAIT_V(6); PG8_BAR;
    }
    for (;;) {
        const bool has_next = S.next(ui + 1, nxt);
        const char* nA = has_next ? (const char*)g.A + (size_t)nxt.pm * tstep : cA; const char* nB = has_next ? (const char*)g.Bt + (size_t)nxt.pn * tstep : cB;
        for (int t = 0; t < nt; t += 2) {
            const bool last = (t == nt - 2);
            const char* a1 = cA + (size_t)(t + 1) * kstep;
            const char* a2 = last ? nA : cA + (size_t)(t + 2) * kstep; const char* b2 = last ? nB : cB + (size_t)(t + 2) * kstep;
            const char* a3 = a2 + kstep; const char* b3 = b2 + kstep;
            if (last && has_next) S.a_ready(nxt);
            if constexpr (SP2) {
            PG8_LDB(B0, 0, 0); PG8_LDB(B1, 0, 1); PG8_SCHED; PG8_LDA(At, 0, 0); PG8_STAGE(PG8_SA(1, 1), a1 + hstep, voffA);
            PG8_WAIT_V(8); PG8_WAIT_L(0); PG8_BAR; PG8_MMA(0, 0, At, B0); PG8_MMA(0, 1, At, B1); PG8_BAR; PG8_SCHED;
            PG8_LDA(At, 0, 1); PG8_STAGE(PG8_SB(0, 0), b2, voffB); PG8_STAGE(PG8_SB(0, 1), b2 + hstep, voffB); PG8_STAGE(PG8_SA(0, 0), a2, voffA);
            PG8_WAIT_V(8); PG8_WAIT_L(0); PG8_BAR; PG8_MMA(1, 0, At, B0); PG8_MMA(1, 1, At, B1); PG8_BAR; PG8_SCHED;
            PG8_LDB(B0, 1, 0); PG8_LDB(B1, 1, 1); PG8_SCHED; PG8_LDA(At, 1, 0); PG8_STAGE(PG8_SA(0, 1), a2 + hstep, voffA);
            PG8_WAIT_V(8); PG8_WAIT_L(0); PG8_BAR; PG8_MMA(0, 0, At, B0); PG8_MMA(0, 1, At, B1); PG8_BAR; PG8_SCHED;
            PG8_LDA(At, 1, 1); PG8_STAGE(PG8_SB(1, 0), b3, voffB); PG8_STAGE(PG8_SB(1, 1), b3 + hstep, voffB); PG8_STAGE(PG8_SA(1, 0), a3, voffA);
            PG8_WAIT_V(8); PG8_WAIT_L(0); PG8_BAR; PG8_MMA(1, 0, At, B0); PG8_MMA(1, 1, At, B1); PG8_BAR; PG8_SCHED;
            } else {
            PG8_LDB(B0, 0, 0); PG8_SCHED; PG8_LDA(At, 0, 0); PG8_STAGE(PG8_SA(1, 1), a1 + hstep, voffA);
            PG8_WAIT_L(8); PG8_BAR; PG8_WAIT_L(0); PG8_MMA(0, 0, At, B0); PG8_BAR; PG8_SCHED;
            PG8_LDB(B1, 0, 1); PG8_STAGE(PG8_SB(0, 0), b2, voffB);
            PG8_BAR; PG8_WAIT_L(0); PG8_MMA(0, 1, At, B1); PG8_BAR;
            PG8_LDA(At, 0, 1); PG8_STAGE(PG8_SA(0, 0), a2, voffA);
            PG8_BAR; PG8_WAIT_L(0); PG8_MMA(1, 0, At, B0); PG8_BAR; PG8_SCHED;
            PG8_STAGE(PG8_SB(0, 1), b2 + hstep, voffB);
            PG8_WAIT_V(6); PG8_BAR; PG8_MMA(1, 1, At, B1); PG8_BAR;
            PG8_LDB(B0, 1, 0); PG8_SCHED; PG8_LDA(At, 1, 0); PG8_STAGE(PG8_SA(0, 1), a2 + hstep, voffA);
            PG8_WAIT_L(8); PG8_BAR; PG8_WAIT_L(0); PG8_MMA(0, 0, At, B0); PG8_BAR; PG8_SCHED;
            PG8_LDB(B1, 1, 1); PG8_STAGE(PG8_SB(1, 0), b3, voffB);
            PG8_BAR; PG8_WAIT_L(0); PG8_MMA(0, 1, At, B1); PG8_BAR;
            PG8_LDA(At, 1, 1); PG8_STAGE(PG8_SA(1, 0), a3, voffA);
            PG8_BAR; PG8_WAIT_L(0); PG8_MMA(1, 0, At, B0); PG8_BAR; PG8_SCHED;
            PG8_STAGE(PG8_SB(1, 1), b3 + hstep, voffB);
            PG8_WAIT_V(6); PG8_BAR; PG8_MMA(1, 1, At, B1); PG8_BAR;
            }
        }
        if constexpr (ALIGN_EPI) { if (wr == 0) PG8_BAR; }
        if constexpr (!Epi::AFTER_DRAIN) { E(acc, cur, wr, wc, fr, fq); S.done(cur); }
        if (!has_next) break;
#pragma unroll
        for (int a = 0; a < 2; ++a)
#pragma unroll
            for (int b = 0; b < 2; ++b)
#pragma unroll
                for (int m = 0; m < 4; ++m)
#pragma unroll
                    for (int n = 0; n < 2; ++n) acc[a][b][m][n] = (f32x4){0.f, 0.f, 0.f, 0.f};
        cur = nxt; cA = nA; cB = nB; ++ui;
        if constexpr (ALIGN_EPI) { if (wr == 1) PG8_BAR; }
    }
    PG8_WAIT_V(0);
    if constexpr (!ALIGN_EPI) { if (wr == 0) PG8_BAR; }
    PG8_BAR;
    if constexpr (Epi::AFTER_DRAIN) { E.fused(acc, cur, wr, wc, fr, fq, lds, wid, lane); S.done(cur); }
#undef PG8_SA
#undef PG8_SB
#undef PG8_STAGE
#undef PG8_LDA
#undef PG8_LDB
#undef PG8_MMA
#undef PG8_WAIT_V
#undef PG8_WAIT_L
#undef PG8_BAR
#undef PG8_SCHED
}
}

namespace pg8 {
__device__ __forceinline__ u32x4 pack8(const f32x4 v0, const f32x4 v1) { u32x4 w; w.x = pkh(v0[0], v0[1]); w.y = pkh(v0[2], v0[3]); w.z = pkh(v1[0], v1[1]); w.w = pkh(v1[2], v1[3]); return w; }
struct EpiProjF {
    static constexpr bool PERM = true, AFTER_DRAIN = false;
    h16* proj; const float* rstd; h16* vsT; h16* vwT; h16* vbT;
    __device__ __forceinline__ void operator()(const f32x4 (&acc)[2][2][4][2], const Unit& u, int wr, int wc, int fr, int fq) const {
        const int row0 = u.pm * BM + wr * 64 + fr, col0 = u.pn * BM + wc * 32 + 8 * fq;
        h16* vt = (u.pn == 3) ? vsT : (u.pn == 4) ? vwT : (u.pn == 7) ? vbT : nullptr;
#pragma unroll
        for (int ai = 0; ai < 2; ++ai)
#pragma unroll
            for (int m = 0; m < 4; ++m) { const int row = row0 + ai * HALF + m * 16; const float rs = rstd[row]; h16* rowp = proj + (size_t)row * PP + col0;
#pragma unroll
                for (int bj = 0; bj < 2; ++bj) { const f32x4 v0 = acc[ai][bj][m][0] * rs, v1 = acc[ai][bj][m][1] * rs;
                    *(u32x4*)(rowp + bj * HALF) = pack8(v0, v1);
                    if (bj == 1 && vt) { h16* q = vt + (size_t)(wc * 32 + 8 * fq) * S + row;
#pragma unroll
                        for (int e = 0; e < 4; ++e) { q[(size_t)e * S] = (h16)v0[e]; q[(size_t)(4 + e) * S] = (h16)v1[e]; } } } }
    }
};
struct EpiRelu2F {
    static constexpr bool PERM = true, AFTER_DRAIN = false;
    h16* a; const float* rstd;
    __device__ __forceinline__ void operator()(const f32x4 (&acc)[2][2][4][2], const Unit& u, int wr, int wc, int fr, int fq) const {
        const int row0 = u.pm * BM + wr * 64 + fr, col0 = u.pn * BM + wc * 32 + 8 * fq;
#pragma unroll
        for (int ai = 0; ai < 2; ++ai)
#pragma unroll
            for (int m = 0; m < 4; ++m) { const int row = row0 + ai * HALF + m * 16; const float rs = rstd[row]; h16* rowp = a + (size_t)row * FF + col0;
#pragma unroll
                for (int bj = 0; bj < 2; ++bj) { f32x4 v0 = acc[ai][bj][m][0] * rs, v1 = acc[ai][bj][m][1] * rs;
#pragma unroll
                    for (int e = 0; e < 4; ++e) { const float p = fmaxf(v0[e], 0.f), q = fmaxf(v1[e], 0.f); v0[e] = p * p; v1[e] = q * q; }
                    *(u32x4*)(rowp + bj * HALF) = pack8(v0, v1); } }
    }
};
template <int SECOND> struct EpiUpF {
    static constexpr bool PERM = true, AFTER_DRAIN = false;
    h16* y; const h16* gate;
    __device__ __forceinline__ void operator()(const f32x4 (&acc)[2][2][4][2], const Unit& u, int wr, int wc, int fr, int fq) const {
        const int row0 = u.pm * BM + wr * 64 + fr, col0 = u.pn * BM + wc * 32 + 8 * fq;
#pragma unroll
        for (int ai = 0; ai < 2; ++ai)
#pragma unroll
            for (int m = 0; m < 4; ++m) { const int row = row0 + ai * HALF + m * 16; h16* rowp = y + (size_t)row * D + col0; const h16* gp = gate + (size_t)row * PP + col0;
#pragma unroll
                for (int bj = 0; bj < 2; ++bj) { const h16x8 gv = *(const h16x8*)(gp + bj * HALF); f32x4 v0 = acc[ai][bj][m][0], v1 = acc[ai][bj][m][1];
                    h16x8 old; if (SECOND) old = *(const h16x8*)(rowp + bj * HALF);
#pragma unroll
                    for (int e = 0; e < 4; ++e) { v0[e] *= sigmoidf_((float)gv[e]); v1[e] *= sigmoidf_((float)gv[4 + e]); if (SECOND) { v0[e] += (float)old[e]; v1[e] += (float)old[4 + e]; } }
                    *(u32x4*)(rowp + bj * HALF) = pack8(v0, v1); } }
    }
};
struct EpiF32F {
    static constexpr bool PERM = false, AFTER_DRAIN = false;
    float* z; int ldz;
    __device__ __forceinline__ void operator()(const f32x4 (&acc)[2][2][4][2], const Unit& u, int wr, int wc, int fr, int fq) const {
        const int row0 = u.pm * BM + wr * 64 + fr, col0 = u.pn * BM + wc * 32 + 4 * fq;
#pragma unroll
        for (int ai = 0; ai < 2; ++ai)
#pragma unroll
            for (int m = 0; m < 4; ++m) { float* rowp = z + (size_t)(row0 + ai * HALF + m * 16) * ldz + col0;
#pragma unroll
                for (int bj = 0; bj < 2; ++bj)
#pragma unroll
                    for (int n = 0; n < 2; ++n) *(f32x4*)(rowp + bj * HALF + n * 16) = acc[ai][bj][m][n]; }
    }
};
}

__device__ __forceinline__ void transpose_item(const float* W, int ldw, int col0, const float* scale, int K, h16* WT, int item, int nblk, LDSP float* scr, int lane) {
    const int kb = item / nblk, nb = item % nblk, k0 = 64 * kb, n0 = 32 * nb;
#pragma unroll 8
    for (int i = 0; i < 32; ++i) { const int kk = 2 * i + (lane >> 5); float v = W[(size_t)(k0 + kk) * ldw + col0 + n0 + (lane & 31)]; if (scale) v *= scale[k0 + kk]; scr[kk * 33 + (lane & 31)] = v; }
    lds_wait();
    const int c = lane & 7;
#pragma unroll
    for (int j = 0; j < 4; ++j) { const int n = (lane >> 3) + 8 * j; const LDSP float* s = scr + (8 * c) * 33 + n;
        u32x4 o; o.x = pkh(s[0 * 33], s[1 * 33]); o.y = pkh(s[2 * 33], s[3 * 33]); o.z = pkh(s[4 * 33], s[5 * 33]); o.w = pkh(s[6 * 33], s[7 * 33]);
        *(u32x4*)(WT + (size_t)(n0 + n) * K + k0 + 8 * c) = o; }
    lds_wait();
}

__device__ __forceinline__ void phase_prologue(Ctx& C) {
    LDSP float* scr = (LDSP float*)(C.lds + C.wave * 16384);
    const float* w_in = C.in[5];
    constexpr int I_WIN_A = 16 * 40, I_WIN_B = 16 * 88, I_WG = 16, I_UP = 8 * 32, I_OUT = 16 * 32, I_W1 = 16 * 128, I_W2 = 64 * 32, I_C1 = 32 * 8, I_C2 = 4 * 2;
    constexpr int NITEMS = I_WIN_A + I_WIN_B + I_WG + 2 * I_UP + I_OUT + I_W1 + I_W2 + 2 * I_C1 + 2 * I_C2;
    for (int it = C.gw; it < NITEMS; it += C.NGW) {
        int r = it;
        if (r < I_WIN_A) { transpose_item(w_in, NIN, 0, C.in[1], D, (h16*)(C.ws + WS_WIN), r, 40, scr, C.lane); continue; } r -= I_WIN_A;
        if (r < I_WIN_B) { transpose_item(w_in, NIN, 1304, C.in[1], D, (h16*)(C.ws + WS_WIN) + (size_t)1280 * D, r, 88, scr, C.lane); continue; } r -= I_WIN_B;
        if (r < I_WG) { transpose_item(w_in, NIN, 1280, C.in[1], D, (h16*)(C.ws + WS_WG), r, 1, scr, C.lane); continue; } r -= I_WG;
        if (r < I_UP) { transpose_item(C.in[14], D, 0, nullptr, 512, (h16*)(C.ws + WS_WUA), r, 32, scr, C.lane); continue; } r -= I_UP;
        if (r < I_UP) { transpose_item(C.in[15], D, 0, nullptr, 512, (h16*)(C.ws + WS_WUB), r, 32, scr, C.lane); continue; } r -= I_UP;
        if (r < I_OUT) { transpose_item(C.in[16], D, 0, nullptr, D, (h16*)(C.ws + WS_WOUT), r, 32, scr, C.lane); continue; } r -= I_OUT;
        if (r < I_W1) { transpose_item(C.in[17], FF, 0, C.in[3], D, (h16*)(C.ws + WS_W1), r, 128, scr, C.lane); continue; } r -= I_W1;
        if (r < I_W2) { transpose_item(C.in[18], D, 0, nullptr, FF, (h16*)(C.ws + WS_W2), r, 32, scr, C.lane); continue; } r -= I_W2;
        if (r < I_C1) { transpose_item(C.in[7], 256, 0, nullptr, 2048, (h16*)(C.ws + WS_CW1K), r, 8, scr, C.lane); continue; } r -= I_C1;
        if (r < I_C1) { transpose_item(C.in[10], 256, 0, nullptr, 2048, (h16*)(C.ws + WS_CW1V), r, 8, scr, C.lane); continue; } r -= I_C1;
        if (r < I_C2) { transpose_item(C.in[8], 64, 0, nullptr, 256, (h16*)(C.ws + WS_CW2K), r, 2, scr, C.lane); continue; } r -= I_C2;
        transpose_item(C.in[11], 64, 0, nullptr, 256, (h16*)(C.ws + WS_CW2V), r, 2, scr, C.lane);
    }
    for (int u = C.gw; u < 16 * 2 * 4; u += C.NGW) {
        const int s = u >> 3, kv = (u >> 2) & 1, nb = u & 3, n = nb * 64 + C.lane;
        const float* pos = C.in[kv ? 9 : 6]; const float* w1 = C.in[kv ? 10 : 7];
        float acc = 0.f;
        for (int k = s * 128; k < s * 128 + 128; ++k) acc += pos[k] * w1[(size_t)k * 256 + n];
        ((float*)(C.ws + WS_CBP))[(s * 2 + kv) * 256 + n] = acc;
    }
    h16* xh = (h16*)(C.ws + WS_R1); float* rstdx = (float*)(C.ws + WS_RSTDX);
    for (int m = C.gw; m < S; m += C.NGW) {
        const f32x4* xr = (const f32x4*)(C.in[0] + (size_t)m * D) + C.lane;
        f32x4 v[4]; float s = 0.f;
#pragma unroll
        for (int j = 0; j < 4; ++j) { v[j] = xr[64 * j]; s += (v[j].x * v[j].x + v[j].y * v[j].y) + (v[j].z * v[j].z + v[j].w * v[j].w); }
        s = wave_sum(s);
        if (C.lane == 0) rstdx[m] = 1.0f / sqrtf(s * (1.0f / D) + EPS);
        unsigned long long* o8 = (unsigned long long*)(xh + (size_t)m * D) + C.lane;
#pragma unroll
        for (int j = 0; j < 4; ++j) o8[64 * j] = (unsigned long long)pkh(v[j].x, v[j].y) | ((unsigned long long)pkh(v[j].z, v[j].w) << 32);
    }
}

template <class Epi>
__device__ __forceinline__ void ngemm(const h16* A1, int lda1, const h16* B1, int K1, const h16* A2, int lda2, const h16* B2, int K2, int M, int N, const Epi& epi, int gw, int NGW, int lane) {
    const int tn_cnt = N / 32, tiles = (M / 32) * tn_cnt, fr = lane & 15, fq = lane >> 4;
    for (int tile = gw; tile < tiles; tile += NGW) {
        const int tm = tile / tn_cnt, tn = tile % tn_cnt;
        f32x4 acc1[2][2], acc2[2][2];
#pragma unroll
        for (int i = 0; i < 2; ++i)
#pragma unroll
            for (int j = 0; j < 2; ++j) { acc1[i][j] = (f32x4){0.f, 0.f, 0.f, 0.f}; acc2[i][j] = (f32x4){0.f, 0.f, 0.f, 0.f}; }
        {
            const h16* a = A1 + (size_t)(tm * 32 + fr) * lda1 + 8 * fq; const h16* b = B1 + (size_t)(tn * 32 + fr) * K1 + 8 * fq;
            for (int k = 0; k < K1; k += 32) {
                const h16x8 a0 = *(const h16x8*)(a + k), a1 = *(const h16x8*)(a + (size_t)16 * lda1 + k);
                const h16x8 b0 = *(const h16x8*)(b + k), b1 = *(const h16x8*)(b + (size_t)16 * K1 + k);
                acc1[0][0] = __builtin_amdgcn_mfma_f32_16x16x32_f16(a0, b0, acc1[0][0], 0, 0, 0);
                acc1[0][1] = __builtin_amdgcn_mfma_f32_16x16x32_f16(a0, b1, acc1[0][1], 0, 0, 0);
                acc1[1][0] = __builtin_amdgcn_mfma_f32_16x16x32_f16(a1, b0, acc1[1][0], 0, 0, 0);
                acc1[1][1] = __builtin_amdgcn_mfma_f32_16x16x32_f16(a1, b1, acc1[1][1], 0, 0, 0);
            }
        }
        if (K2 > 0) {
            const h16* a = A2 + (size_t)(tm * 32 + fr) * lda2 + 8 * fq; const h16* b = B2 + (size_t)(tn * 32 + fr) * K2 + 8 * fq;
            for (int k = 0; k < K2; k += 32) {
                const h16x8 a0 = *(const h16x8*)(a + k), a1 = *(const h16x8*)(a + (size_t)16 * lda2 + k);
                const h16x8 b0 = *(const h16x8*)(b + k), b1 = *(const h16x8*)(b + (size_t)16 * K2 + k);
                acc2[0][0] = __builtin_amdgcn_mfma_f32_16x16x32_f16(a0, b0, acc2[0][0], 0, 0, 0);
                acc2[0][1] = __builtin_amdgcn_mfma_f32_16x16x32_f16(a0, b1, acc2[0][1], 0, 0, 0);
                acc2[1][0] = __builtin_amdgcn_mfma_f32_16x16x32_f16(a1, b0, acc2[1][0], 0, 0, 0);
                acc2[1][1] = __builtin_amdgcn_mfma_f32_16x16x32_f16(a1, b1, acc2[1][1], 0, 0, 0);
            }
        }
#pragma unroll
        for (int i = 0; i < 2; ++i)
#pragma unroll
            for (int j = 0; j < 2; ++j)
#pragma unroll
                for (int r = 0; r < 4; ++r) epi(tm * 32 + 16 * i + 4 * fq + r, tn * 32 + 16 * j + fr, acc1[i][j][r], acc2[i][j][r]);
    }
}

struct EpiProj {
    h16* proj; const float* rstd; h16* vsT; h16* vwT; h16* vbT;
    __device__ __forceinline__ void operator()(int row, int col, float v, float) const {
        const h16 o = (h16)(v * rstd[row]);
        proj[(size_t)row * PP + col] = o;
        if (col >= C_VS && col < C_VS + 128) vsT[(size_t)(col - C_VS) * S + row] = o;
        else if (col >= C_VW && col < C_VW + 128) vwT[(size_t)(col - C_VW) * S + row] = o;
        else if (col >= C_VSW && col < C_VSW + 128) vbT[(size_t)(col - C_VSW) * S + row] = o;
    }
};
struct EpiUp {
    h16* y; const h16* proj;
    __device__ __forceinline__ void operator()(int row, int col, float v1, float v2) const {
        const float ga = (float)proj[(size_t)row * PP + C_GA + col], gb = (float)proj[(size_t)row * PP + C_GB + col];
        y[(size_t)row * D + col] = (h16)(sigmoidf_(ga) * v1 + sigmoidf_(gb) * v2);
    }
};
struct EpiF32 { float* z; int ldz;
    __device__ __forceinline__ void operator()(int row, int col, float v, float) const { z[(size_t)row * ldz + col] = v; } };
struct EpiRelu2 { h16* a; const float* rstd;
    __device__ __forceinline__ void operator()(int row, int col, float v, float) const { float u = fmaxf(v * rstd[row], 0.f); a[(size_t)row * FF + col] = (h16)(u * u); } };

__device__ __forceinline__ float gelu_tanh(float x) { const float u = 0.7978845608028654f * (x + 0.044715f * x * x * x); return 0.5f * x * (1.0f + tanhf(u)); }
__device__ __forceinline__ void phase_compress_naive(Ctx& C) {
    LDSP float* hs = (LDSP float*)(C.lds + C.wave * 2048);
    const h16* proj = (const h16*)(C.ws + WS_R0);
    const float* cbp = (const float*)(C.ws + WS_CBP);
    for (int u = C.gw; u < 2 * NCMP * 2; u += C.NGW) {
        const int kv = u / (NCMP * 2), rem = u % (NCMP * 2), i = rem >> 1, g = rem & 1;
        const h16* w1T = (const h16*)(C.ws + (kv ? WS_CW1V : WS_CW1K)); const h16* w2T = (const h16*)(C.ws + (kv ? WS_CW2V : WS_CW2K));
        const int col = (kv ? C_VC : C_KC) + g * 64;
        float acc[4];
#pragma unroll
        for (int m = 0; m < 4; ++m) { float b = 0.f; for (int s = 0; s < 16; ++s) b += cbp[(s * 2 + kv) * 256 + C.lane + 64 * m]; acc[m] = b; }
        for (int j = 0; j < 32; ++j) {
            const h16* xr = proj + (size_t)(16 * i + j) * PP + col;
#pragma unroll
            for (int c = 0; c < 8; ++c) {
                const h16x8 xv = *(const h16x8*)(xr + 8 * c);
#pragma unroll
                for (int m = 0; m < 4; ++m) { const h16x8 wv = *(const h16x8*)(w1T + (size_t)(C.lane + 64 * m) * 2048 + j * 64 + 8 * c);
#pragma unroll
                    for (int e = 0; e < 8; ++e) acc[m] += (float)xv[e] * (float)wv[e]; }
            }
        }
#pragma unroll
        for (int m = 0; m < 4; ++m) hs[C.lane + 64 * m] = gelu_tanh(acc[m]);
        lds_wait();
        float o = 0.f;
        for (int n = 0; n < 256; n += 8) { const h16x8 wv = *(const h16x8*)(w2T + (size_t)C.lane * 256 + n);
#pragma unroll
            for (int e = 0; e < 8; ++e) o += hs[n + e] * (float)wv[e]; }
        lds_wait();
        if (kv == 0) ((h16*)(C.ws + WS_KC))[((size_t)i * 2 + g) * 64 + C.lane] = (h16)o;
        else { ((h16*)(C.ws + WS_VCR))[((size_t)i * 2 + g) * 64 + C.lane] = (h16)o; ((h16*)(C.ws + WS_VCT))[((size_t)g * 64 + C.lane) * 1024 + i] = (h16)o; }
    }
}

__device__ __forceinline__ void build_bucket_table(Ctx& C, LDSP unsigned char* buck) {
    for (int d = C.tid; d < 1024; d += NTHR) {
        int b;
        if (d < 16) b = d;
        else { const float x = (float)d / 16.0f; int l = 16 + (int)(logf(x) / 4.158883083359672f * 16.0f); b = l < 31 ? l : 31; }
        buck[d] = (unsigned char)b;
    }
    __syncthreads();
}

template <int MODE, int NB>
__device__ __forceinline__ void nattn(Ctx& C, int t, int g, LDSP float* scr, const LDSP unsigned char* buck, float (&o)[4]) {
    LDSP float* qs = scr; LDSP float* sc = scr + 256;
    const h16* proj = (const h16*)(C.ws + WS_R0);
    const int lane = C.lane;
    { const h16x4 qv = *(const h16x4*)(proj + (size_t)t * PP + (MODE == 3 ? C_QS : C_QN) + g * 256 + lane * 4);
#pragma unroll
      for (int e = 0; e < 4; ++e) qs[lane * 4 + e] = (float)qv[e]; }
    lds_wait();
    const int cur = t >> 6;
    const int nvalid = (t >= 31) ? (((t - 31) >> 4) + 1) : 0;
    const int nsel = (cur + 1) < 16 ? (cur + 1) : 16;
    const unsigned char* idxp = (const unsigned char*)(C.ws + WS_IDX) + ((size_t)t * 2 + g) * 16;
    const float* relb = C.in[13] + (MODE == 3 ? 8 : 0) + g * 4;
    const int kcol = (MODE == 1 ? C_KS : MODE == 2 ? C_KW : C_KSW) + g * 64;
    const int vcol = (MODE == 1 ? C_VS : MODE == 2 ? C_VW : C_VSW) + g * 64;
    const int nb = (MODE == 1) ? nsel : NB;
    float mx[4] = {-INFINITY, -INFINITY, -INFINITY, -INFINITY};
#pragma unroll 1
    for (int b = 0; b < nb; ++b) {
        int pos = 0; bool valid; const h16* krow;
        if (MODE == 0) { const int n = b * 64 + lane; valid = n < nvalid; krow = (const h16*)(C.ws + WS_KC) + ((size_t)(n < 1022 ? n : 1022) * 2 + g) * 64; }
        else {
            if (MODE == 1) { const int bid = (int)idxp[b]; pos = bid * 64 + lane; valid = (pos <= t); }
            else if (MODE == 2) { pos = t - 511 + 64 * b + lane; valid = pos >= 0; }
            else { pos = t - 127 + 64 * b + lane; valid = pos >= 0; }
            const int pc = pos < 0 ? 0 : pos;
            krow = proj + (size_t)pc * PP + kcol;
        }
        float a0 = 0.f, a1 = 0.f, a2 = 0.f, a3 = 0.f;
#pragma unroll 2
        for (int c = 0; c < 8; ++c) { const h16x8 kv = *(const h16x8*)(krow + 8 * c);
#pragma unroll
            for (int e = 0; e < 8; ++e) { const float kf = (float)kv[e]; a0 += qs[8 * c + e] * kf; a1 += qs[64 + 8 * c + e] * kf; a2 += qs[128 + 8 * c + e] * kf; a3 += qs[192 + 8 * c + e] * kf; } }
        float b0 = 0.f, b1 = 0.f, b2 = 0.f, b3 = 0.f;
        if (MODE != 0) { int dist = t - pos; dist = dist < 0 ? 0 : (dist > 1023 ? 1023 : dist); const int bk = buck[dist]; b0 = relb[bk * 16 + 0]; b1 = relb[bk * 16 + 1]; b2 = relb[bk * 16 + 2]; b3 = relb[bk * 16 + 3]; }
        a0 = valid ? a0 * 0.125f + b0 : -INFINITY; a1 = valid ? a1 * 0.125f + b1 : -INFINITY;
        a2 = valid ? a2 * 0.125f + b2 : -INFINITY; a3 = valid ? a3 * 0.125f + b3 : -INFINITY;
        sc[b * 64 + lane] = a0; sc[1024 + b * 64 + lane] = a1; sc[2048 + b * 64 + lane] = a2; sc[3072 + b * 64 + lane] = a3;
        mx[0] = fmaxf(mx[0], a0); mx[1] = fmaxf(mx[1], a1); mx[2] = fmaxf(mx[2], a2); mx[3] = fmaxf(mx[3], a3);
    }
    float inv[4];
#pragma unroll
    for (int h = 0; h < 4; ++h) {
        float m = wave_max(mx[h]);
        float sk = 0.f;
        if (MODE == 3) { sk = C.in[12][g * 4 + h]; m = fmaxf(m, sk); }
        const float ms = (m == -INFINITY) ? 0.f : m;
        float l = 0.f;
#pragma unroll 1
        for (int b = 0; b < nb; ++b) { const float e = __expf(sc[h * 1024 + b * 64 + lane] - ms); sc[h * 1024 + b * 64 + lane] = e; l += e; }
        l = wave_sum(l);
        if (MODE == 3) l += __expf(sk - ms);
        inv[h] = 1.0f / fmaxf(l, 1e-30f);
    }
    lds_wait();
    if (MODE == 0) {
        float scv[4];
#pragma unroll
        for (int c = 0; c < 4; ++c) { const int j = lane + 64 * c; float v = 0.f;
#pragma unroll 1
            for (int oo = 0; oo < 5; ++oo) { const int n = 4 * j + oo - 1; if (n >= 0 && n < NCMP) v += (sc[n] * inv[0] + sc[1024 + n] * inv[1]) + (sc[2048 + n] * inv[2] + sc[3072 + n] * inv[3]); }
            const bool val = j <= cur, forced = (j == 0) || (j == cur) || (j == cur - 1);
            scv[c] = val ? (forced ? INFINITY : v) : -INFINITY; }
        unsigned char* idxw = (unsigned char*)(C.ws + WS_IDX) + ((size_t)t * 2 + g) * 16;
#pragma unroll 1
        for (int it = 0; it < 16; ++it) {
            float bv = scv[0]; int bj = lane;
#pragma unroll
            for (int c = 1; c < 4; ++c) if (scv[c] > bv) { bv = scv[c]; bj = lane + 64 * c; }
#pragma unroll
            for (int of = 32; of >= 1; of >>= 1) { const float ov = __shfl_xor(bv, of); const int oj = __shfl_xor(bj, of); if (ov > bv || (ov == bv && oj < bj)) { bv = ov; bj = oj; } }
            if (bv == -INFINITY) bj = 0;
            if (lane == 0) idxw[it] = (unsigned char)bj;
#pragma unroll
            for (int c = 0; c < 4; ++c) if (bj == lane + 64 * c) scv[c] = -INFINITY;
        }
    }
    float x0 = 0.f, x1 = 0.f, x2 = 0.f, x3 = 0.f;
    if (MODE == 0) {
        const h16* V = (const h16*)(C.ws + WS_VCR) + g * 64 + lane;
#pragma unroll 2
        for (int n = 0; n < nvalid; ++n) { const float v = (float)V[(size_t)n * 128]; x0 += sc[n] * v; x1 += sc[1024 + n] * v; x2 += sc[2048 + n] * v; x3 += sc[3072 + n] * v; }
    } else {
#pragma unroll 1
        for (int b = 0; b < nb; ++b) {
            const int p0 = (MODE == 1) ? (int)idxp[b] * 64 : (MODE == 2 ? t - 511 + 64 * b : t - 127 + 64 * b);
#pragma unroll 2
            for (int i = 0; i < 64; ++i) { int pos = p0 + i; pos = pos < 0 ? 0 : (pos > S - 1 ? S - 1 : pos);
                const float v = (float)proj[(size_t)pos * PP + vcol + lane]; const int k = b * 64 + i;
                x0 += sc[k] * v; x1 += sc[1024 + k] * v; x2 += sc[2048 + k] * v; x3 += sc[3072 + k] * v; }
        }
    }
    o[0] = x0 * inv[0]; o[1] = x1 * inv[1]; o[2] = x2 * inv[2]; o[3] = x3 * inv[3];
    lds_wait();
}

__device__ __forceinline__ void phase_cmp_swa_naive(Ctx& C) {
    LDSP unsigned char* buck = C.lds; LDSP float* scr = (LDSP float*)(C.lds + 1024 + C.wave * 17408);
    build_bucket_table(C, buck);
    h16* oa = (h16*)(C.ws + WS_OA); h16* ob = (h16*)(C.ws + WS_OB);
    for (int u = C.gw; u < 2 * S * 2; u += C.NGW) {
        const int which = u / (S * 2), r = u % (S * 2), t = r >> 1, g = r & 1; float o[4];
        if (which == 0) {
#if USE_MFMA_P3 && USE_MFMA_CMP
            continue;
#endif
            nattn<0, 16>(C, t, g, scr, buck, o);
#pragma unroll
            for (int h = 0; h < 4; ++h) oa[(size_t)t * 512 + (g * 4 + h) * 64 + C.lane] = (h16)o[h]; }
        else {
#if USE_MFMA_P3 && USE_MFMA_SWA
            continue;
#endif
            nattn<3, 2>(C, t, g, scr, buck, o);
#pragma unroll
            for (int h = 0; h < 4; ++h) ob[(size_t)t * 512 + (g * 4 + h) * 64 + C.lane] = (h16)o[h]; }
    }
}
__device__ __forceinline__ void phase_selwin_naive(Ctx& C) {
    LDSP unsigned char* buck = C.lds; LDSP float* scr = (LDSP float*)(C.lds + 1024 + C.wave * 17408);
    build_bucket_table(C, buck);
    h16* oa = (h16*)(C.ws + WS_OA);
    const h16* xh = (const h16*)(C.ws + WS_R1); const h16* WgT = (const h16*)(C.ws + WS_WG); const float* rstdx = (const float*)(C.ws + WS_RSTDX);
    for (int u = C.gw; u < S * 2; u += C.NGW) {
        const int t = u >> 1, g = u & 1; float os[4], ow[4];
        nattn<1, 16>(C, t, g, scr, buck, os);
        nattn<2, 8>(C, t, g, scr, buck, ow);
        const h16x8 x0 = *(const h16x8*)(xh + (size_t)t * D + C.lane * 16), x1 = *(const h16x8*)(xh + (size_t)t * D + C.lane * 16 + 8);
        float gt[12]; const float rs = rstdx[t];
#pragma unroll
        for (int c = 0; c < 12; ++c) { const h16* wr = WgT + (size_t)(g * 12 + c) * D + C.lane * 16; const h16x8 w0 = *(const h16x8*)wr, w1 = *(const h16x8*)(wr + 8); float a = 0.f;
#pragma unroll
            for (int e = 0; e < 8; ++e) a += (float)x0[e] * (float)w0[e] + (float)x1[e] * (float)w1[e];
            gt[c] = sigmoidf_(wave_sum(a) * rs); }
#pragma unroll
        for (int h = 0; h < 4; ++h) { h16* p = oa + (size_t)t * 512 + (g * 4 + h) * 64 + C.lane; const float oc = (float)*p;
            *p = (h16)(gt[h * 3 + 0] * oc + gt[h * 3 + 1] * os[h] + gt[h * 3 + 2] * ow[h]); }
    }
}

typedef float f32x4a __attribute__((ext_vector_type(4)));
#define MFMA16(a, b, c) __builtin_amdgcn_mfma_f32_16x16x32_f16((a), (b), (c), 0, 0, 0)
__device__ __forceinline__ h16x8 pack_p(const f32x4 a, const f32x4 b) {
    h16x8 r; r[0] = (h16)a[0]; r[1] = (h16)a[1]; r[2] = (h16)a[2]; r[3] = (h16)a[3]; r[4] = (h16)b[0]; r[5] = (h16)b[1]; r[6] = (h16)b[2]; r[7] = (h16)b[3]; return r;
}
__device__ __forceinline__ h16x8 cat44(const h16x4 a, const h16x4 b) { h16x8 r; r[0] = a[0]; r[1] = a[1]; r[2] = a[2]; r[3] = a[3]; r[4] = b[0]; r[5] = b[1]; r[6] = b[2]; r[7] = b[3]; return r; }
__device__ __forceinline__ float xmax4(float v) { v = fmaxf(v, __shfl_xor(v, 16)); v = fmaxf(v, __shfl_xor(v, 32)); return v; }
__device__ __forceinline__ float xsum4(float v) { v += __shfl_xor(v, 16); v += __shfl_xor(v, 32); return v; }

__device__ __forceinline__ void build_band_table(Ctx& C, LDSP float* tab, int NB, int headcol0) {
    for (int i = C.tid; i < NB * 4; i += NTHR) {
        const int d = i >> 2, h = i & 3; int b;
        if (d < 16) b = d; else { const float x = (float)d / 16.0f; int l = 16 + (int)(logf(x) / 4.158883083359672f * 16.0f); b = l < 31 ? l : 31; }
        tab[i] = C.in[13][b * 16 + headcol0 + h];
    }
}

template <int MODE>
__device__ __forceinline__ void band_unit(Ctx& C, int t0, int g, const LDSP float* tab, int NBT, h16* outp) {
    constexpr int W = (MODE == 2) ? 512 : 128, NPAIR = W / 32 + 1;
    const int lane = C.lane, fr = lane & 15, fq = lane >> 4;
    const h16* proj = (const h16*)(C.ws + WS_R0);
    const int qcol = (MODE == 2 ? C_QN : C_QS) + g * 256, kcol = (MODE == 2 ? C_KW : C_KSW) + g * 64;
    const h16* VT = (const h16*)(C.ws + (MODE == 2 ? WS_VWT : WS_VBT)) + (size_t)g * 64 * S;
    h16x8 qf[4][2];
#pragma unroll
    for (int c = 0; c < 4; ++c)
#pragma unroll
        for (int ks = 0; ks < 2; ++ks) qf[c][ks] = *(const h16x8*)(proj + (size_t)(t0 + fr) * PP + qcol + c * 64 + 32 * ks + 8 * fq);
    f32x4 O[4][4]; float m[4], l[4];
#pragma unroll
    for (int c = 0; c < 4; ++c) {
#pragma unroll
        for (int dt = 0; dt < 4; ++dt) O[c][dt] = (f32x4){0.f, 0.f, 0.f, 0.f};
        if (MODE == 3) { m[c] = C.in[12][g * 4 + c]; l[c] = (fq == 0) ? 1.0f : 0.0f; } else { m[c] = -INFINITY; l[c] = 0.f; }
    }
    const int kbase = t0 + 16 - 32 * NPAIR;
#pragma unroll 1
    for (int p = 0; p < NPAIR; ++p) {
        const int k0 = kbase + 32 * p;
        if (k0 + 32 <= 0) continue;
        h16x8 kf[2][2];
#pragma unroll
        for (int T = 0; T < 2; ++T) { int key = k0 + 16 * T + fr; key = key < 0 ? 0 : key;
#pragma unroll
            for (int ks = 0; ks < 2; ++ks) kf[T][ks] = *(const h16x8*)(proj + (size_t)key * PP + kcol + 32 * ks + 8 * fq); }
        h16x4 va[4][2];
        { int ka = k0 + 4 * fq, kb = k0 + 16 + 4 * fq; ka = ka < 0 ? 0 : ka; kb = kb < 0 ? 0 : kb;
#pragma unroll
          for (int dt = 0; dt < 4; ++dt) { const h16* vr = VT + (size_t)(16 * dt + fr) * S; va[dt][0] = *(const h16x4*)(vr + ka); va[dt][1] = *(const h16x4*)(vr + kb); } }
        f32x4 Sx[4][2];
#pragma unroll
        for (int c = 0; c < 4; ++c)
#pragma unroll
            for (int T = 0; T < 2; ++T) { f32x4 z = (f32x4){0.f, 0.f, 0.f, 0.f}; z = MFMA16(kf[T][0], qf[c][0], z); Sx[c][T] = MFMA16(kf[T][1], qf[c][1], z); }
#pragma unroll
        for (int T = 0; T < 2; ++T)
#pragma unroll
            for (int r = 0; r < 4; ++r) {
                const int key = k0 + 16 * T + 4 * fq + r, dist = t0 + fr - key;
                const bool valid = (dist >= 0) && (dist < W) && (key >= 0);
                int dc = dist < 0 ? 0 : (dist > NBT - 1 ? NBT - 1 : dist);
                const f32x4 b4 = *(const LDSP f32x4*)(tab + dc * 4);
#pragma unroll
                for (int c = 0; c < 4; ++c) Sx[c][T][r] = valid ? Sx[c][T][r] * 0.125f + b4[c] : -INFINITY;
            }
        h16x8 pf[4];
#pragma unroll
        for (int c = 0; c < 4; ++c) {
            float tm = fmaxf(fmaxf(fmaxf(Sx[c][0][0], Sx[c][0][1]), fmaxf(Sx[c][0][2], Sx[c][0][3])), fmaxf(fmaxf(Sx[c][1][0], Sx[c][1][1]), fmaxf(Sx[c][1][2], Sx[c][1][3])));
            tm = xmax4(tm);
            const float mn = fmaxf(m[c], tm), ms = (mn == -INFINITY) ? 0.f : mn;
            if (__builtin_amdgcn_ballot_w64(mn != m[c]) != 0ull) {
                const float alpha = __expf(m[c] - ms);
                l[c] *= alpha;
#pragma unroll
                for (int dt = 0; dt < 4; ++dt) O[c][dt] = O[c][dt] * alpha;
                m[c] = mn;
            }
            float ps = 0.f;
#pragma unroll
            for (int T = 0; T < 2; ++T)
#pragma unroll
                for (int r = 0; r < 4; ++r) { const float e = __expf(Sx[c][T][r] - ms); Sx[c][T][r] = e; ps += e; }
            l[c] += ps;
            pf[c] = pack_p(Sx[c][0], Sx[c][1]);
        }
#pragma unroll
        for (int dt = 0; dt < 4; ++dt) { const h16x8 vf = cat44(va[dt][0], va[dt][1]);
#pragma unroll
            for (int c = 0; c < 4; ++c) O[c][dt] = MFMA16(vf, pf[c], O[c][dt]); }
    }
#pragma unroll
    for (int c = 0; c < 4; ++c) {
        const float inv = 1.0f / fmaxf(xsum4(l[c]), 1e-30f);
        h16* op = outp + (size_t)(t0 + fr) * 512 + (g * 4 + c) * 64 + 4 * fq;
#pragma unroll
        for (int dt = 0; dt < 4; ++dt) { const f32x4 v = O[c][dt] * inv; h16x4 hv; hv[0] = (h16)v[0]; hv[1] = (h16)v[1]; hv[2] = (h16)v[2]; hv[3] = (h16)v[3]; *(h16x4*)(op + 16 * dt) = hv; }
    }
}

__device__ __forceinline__ void cmp_unit(Ctx& C, int t0, int g, LDSP float* psl  ) {
    const int lane = C.lane, fr = lane & 15, fq = lane >> 4;
    const h16* proj = (const h16*)(C.ws + WS_R0);
    const h16* Kc = (const h16*)(C.ws + WS_KC) + g * 64; const h16* VcT = (const h16*)(C.ws + WS_VCT) + (size_t)g * 64 * 1024;
    h16x8 qf[4][2];
#pragma unroll
    for (int c = 0; c < 4; ++c)
#pragma unroll
        for (int ks = 0; ks < 2; ++ks) qf[c][ks] = *(const h16x8*)(proj + (size_t)(t0 + fr) * PP + C_QN + g * 256 + c * 64 + 32 * ks + 8 * fq);
    const int tl = t0 + 15, nmax = (tl >= 31) ? (((tl - 31) >> 4) + 1) : 0, npair = (nmax + 31) >> 5;
    const int tq = t0 + fr, nv = (tq >= 31) ? (((tq - 31) >> 4) + 1) : 0;
    float m[4], l[4];
#pragma unroll
    for (int c = 0; c < 4; ++c) { m[c] = -INFINITY; l[c] = 0.f; }
#pragma unroll 1
    for (int p = 0; p < npair; ++p) {
        const int k0 = 32 * p;
        h16x8 kf[2][2];
#pragma unroll
        for (int T = 0; T < 2; ++T) { int n = k0 + 16 * T + fr; n = n > 1022 ? 1022 : n;
#pragma unroll
            for (int ks = 0; ks < 2; ++ks) kf[T][ks] = *(const h16x8*)(Kc + (size_t)n * 128 + 32 * ks + 8 * fq); }
#pragma unroll
        for (int c = 0; c < 4; ++c) {
            f32x4 s0 = (f32x4){0.f, 0.f, 0.f, 0.f}, s1 = s0;
            s0 = MFMA16(kf[0][0], qf[c][0], s0); s0 = MFMA16(kf[0][1], qf[c][1], s0);
            s1 = MFMA16(kf[1][0], qf[c][0], s1); s1 = MFMA16(kf[1][1], qf[c][1], s1);
            float tm = -INFINITY;
#pragma unroll
            for (int r = 0; r < 4; ++r) { const int n0 = k0 + 4 * fq + r; s0[r] = (n0 < nv) ? s0[r] * 0.125f : -INFINITY; s1[r] = (n0 + 16 < nv) ? s1[r] * 0.125f : -INFINITY; tm = fmaxf(tm, fmaxf(s0[r], s1[r])); }
            tm = xmax4(tm);
            const float mn = fmaxf(m[c], tm), ms = (mn == -INFINITY) ? 0.f : mn;
            float ps = 0.f;
#pragma unroll
            for (int r = 0; r < 4; ++r) ps += __expf(s0[r] - ms) + __expf(s1[r] - ms);
            l[c] = l[c] * __expf(m[c] - ms) + ps; m[c] = mn;
        }
    }
    float inv[4], msf[4];
#pragma unroll
    for (int c = 0; c < 4; ++c) { inv[c] = 1.0f / fmaxf(xsum4(l[c]), 1e-30f); msf[c] = (m[c] == -INFINITY) ? 0.f : m[c]; }
    for (int i = lane; i < 16 * 260; i += 64) psl[i] = 0.f;
    lds_wait();
    f32x4 O[4][4];
#pragma unroll
    for (int c = 0; c < 4; ++c)
#pragma unroll
        for (int dt = 0; dt < 4; ++dt) O[c][dt] = (f32x4){0.f, 0.f, 0.f, 0.f};
#pragma unroll 1
    for (int p = 0; p < npair; ++p) {
        const int k0 = 32 * p;
        h16x8 kf[2][2];
#pragma unroll
        for (int T = 0; T < 2; ++T) { int n = k0 + 16 * T + fr; n = n > 1022 ? 1022 : n;
#pragma unroll
            for (int ks = 0; ks < 2; ++ks) kf[T][ks] = *(const h16x8*)(Kc + (size_t)n * 128 + 32 * ks + 8 * fq); }
        h16x4 va[4][2];
#pragma unroll
        for (int dt = 0; dt < 4; ++dt) { const h16* vr = VcT + (size_t)(16 * dt + fr) * 1024 + k0 + 4 * fq; va[dt][0] = *(const h16x4*)vr; va[dt][1] = *(const h16x4*)(vr + 16); }
        f32x4 pg0 = (f32x4){0.f, 0.f, 0.f, 0.f}, pg1 = pg0; h16x8 pf[4];
#pragma unroll
        for (int c = 0; c < 4; ++c) {
            f32x4 s0 = (f32x4){0.f, 0.f, 0.f, 0.f}, s1 = s0;
            s0 = MFMA16(kf[0][0], qf[c][0], s0); s0 = MFMA16(kf[0][1], qf[c][1], s0);
            s1 = MFMA16(kf[1][0], qf[c][0], s1); s1 = MFMA16(kf[1][1], qf[c][1], s1);
#pragma unroll
            for (int r = 0; r < 4; ++r) { const int n0 = k0 + 4 * fq + r;
                s0[r] = (n0 < nv) ? __expf(s0[r] * 0.125f - msf[c]) * inv[c] : 0.f; s1[r] = (n0 + 16 < nv) ? __expf(s1[r] * 0.125f - msf[c]) * inv[c] : 0.f; }
            pg0 += s0; pg1 += s1; pf[c] = pack_p(s0, s1);
        }
        {
            const int j0 = (k0 >> 2) + fq, j1 = j0 + 4;
            LDSP float* pr = psl + fr * 260;
            pr[j0] += (pg0[0] + pg0[1]) + (pg0[2] + pg0[3]); lds_wait();
            pr[j0 + 1] += pg0[3]; lds_wait();
            pr[j1] += (pg1[0] + pg1[1]) + (pg1[2] + pg1[3]); lds_wait();
            pr[j1 + 1] += pg1[3]; lds_wait();
        }
#pragma unroll
        for (int dt = 0; dt < 4; ++dt) { const h16x8 vf = cat44(va[dt][0], va[dt][1]);
#pragma unroll
            for (int c = 0; c < 4; ++c) O[c][dt] = MFMA16(vf, pf[c], O[c][dt]); }
    }
    h16* oa = (h16*)(C.ws + WS_OA);
#pragma unroll
    for (int c = 0; c < 4; ++c) { h16* op = oa + (size_t)(t0 + fr) * 512 + (g * 4 + c) * 64 + 4 * fq;
#pragma unroll
        for (int dt = 0; dt < 4; ++dt) { const f32x4 v = O[c][dt]; h16x4 hv; hv[0] = (h16)v[0]; hv[1] = (h16)v[1]; hv[2] = (h16)v[2]; hv[3] = (h16)v[3]; *(h16x4*)(op + 16 * dt) = hv; } }
    lds_wait();
#pragma unroll 1
    for (int q = 0; q < 16; ++q) {
        const int t = t0 + q, cur = t >> 6;
        float scv[4];
#pragma unroll
        for (int c = 0; c < 4; ++c) { const int j = lane + 64 * c; const float v = psl[q * 260 + j];
            const bool val = j <= cur, forced = (j == 0) || (j == cur) || (j == cur - 1);
            scv[c] = val ? (forced ? INFINITY : v) : -INFINITY; }
        unsigned char* idxw = (unsigned char*)(C.ws + WS_IDX) + ((size_t)t * 2 + g) * 16;
#pragma unroll 1
        for (int it = 0; it < 16; ++it) {
            float bv = scv[0]; int bj = lane;
#pragma unroll
            for (int c = 1; c < 4; ++c) if (scv[c] > bv) { bv = scv[c]; bj = lane + 64 * c; }
#pragma unroll
            for (int of = 32; of >= 1; of >>= 1) { const float ov = __shfl_xor(bv, of); const int oj = __shfl_xor(bj, of); if (ov > bv || (ov == bv && oj < bj)) { bv = ov; bj = oj; } }
            if (bv == -INFINITY) bj = 0;
            if (lane == 0) idxw[it] = (unsigned char)bj;
#pragma unroll
            for (int c = 0; c < 4; ++c) if (bj == lane + 64 * c) scv[c] = -INFINITY;
        }
    }
}

__device__ __forceinline__ void gate_unit(Ctx& C, int t0) {
    const int lane = C.lane, fr = lane & 15, fq = lane >> 4;
    const h16* xh = (const h16*)(C.ws + WS_R1) + (size_t)(t0 + fr) * D + 8 * fq; const h16* wg = (const h16*)(C.ws + WS_WG) + (size_t)fr * D + 8 * fq;
    f32x4 a0 = (f32x4){0.f, 0.f, 0.f, 0.f}, a1 = a0;
#pragma unroll 4
    for (int k = 0; k < D; k += 32) { const h16x8 xa = *(const h16x8*)(xh + k); const h16x8 w0 = *(const h16x8*)(wg + k), w1 = *(const h16x8*)(wg + (size_t)16 * D + k);
        a0 = MFMA16(xa, w0, a0); a1 = MFMA16(xa, w1, a1); }
    const float* rstd = (const float*)(C.ws + WS_RSTDX); float* GS = (float*)(C.ws + WS_GS);
#pragma unroll
    for (int r = 0; r < 4; ++r) { const int t = t0 + 4 * fq + r; const float rs = rstd[t];
        GS[(size_t)t * 24 + fr] = sigmoidf_(a0[r] * rs); if (fr < 8) GS[(size_t)t * 24 + 16 + fr] = sigmoidf_(a1[r] * rs); }
}

__device__ __forceinline__ void phase3_mfma(Ctx& C) {
    LDSP float* tabw = (LDSP float*)(C.lds);
    LDSP float* tabs = (LDSP float*)(C.lds + 17408);
    LDSP float* psl = (LDSP float*)(C.lds + 22528 + C.wave * 16640);
    build_band_table(C, tabw, 544, 0); build_band_table(C, tabw + 544 * 4, 544, 4);
    build_band_table(C, tabs, 160, 8); build_band_table(C, tabs + 160 * 4, 160, 12);
    __syncthreads();
    constexpr int NT = S / 16;
    const int NU = NT * 2   + NT * 2   + NT * 2   + NT  ;
    for (int u = C.gw; u < NU; u += C.NGW) {
        int r = u;
        if (r < NT * 2) { const int tile = NT - 1 - (r >> 1), g = r & 1;
#if USE_MFMA_CMP
            cmp_unit(C, tile * 16, g, psl);
#endif
            continue; } r -= NT * 2;
        if (r < NT * 2) { band_unit<2>(C, (r >> 1) * 16, r & 1, tabw + (r & 1) * 544 * 4, 544, (h16*)(C.ws + WS_OW)); continue; } r -= NT * 2;
        if (r < NT * 2) {
#if USE_MFMA_SWA
            band_unit<3>(C, (r >> 1) * 16, r & 1, tabs + (r & 1) * 160 * 4, 160, (h16*)(C.ws + WS_OB));
#endif
            continue; } r -= NT * 2;
        gate_unit(C, r * 16);
    }
}

constexpr int SEL_ROWB = 144;
constexpr int SEL_TABH = 1032;
__device__ __forceinline__ void build_sel_table(Ctx& C, LDSP float* tab) {
    for (int i = C.tid; i < 8 * 1024; i += NTHR) {
        const int gh = i >> 10, d = i & 1023; int b;
        if (d < 16) b = d; else { const float x = (float)d / 16.0f; int l = 16 + (int)(logf(x) / 4.158883083359672f * 16.0f); b = l < 31 ? l : 31; }
        tab[gh * SEL_TABH + d] = C.in[13][b * 16 + gh];
    }
}
__device__ __forceinline__ void sel_wg_unit(Ctx& C, int qb, int g, LDSP unsigned char* Kl, LDSP unsigned char* Vl, const LDSP float* tabg  , LDSP unsigned* mskw  ) {
    const int lane = C.lane, fr = lane & 15, fq = lane >> 4, qi = fr >> 2, hd = fr & 3, w = C.wave;
    const h16* proj = (const h16*)(C.ws + WS_R0);
    const h16* vsT = (const h16*)(C.ws + WS_VST) + (size_t)g * 64 * S;
    const int tq0 = qb * 64 + 8 * w;
    for (int i = lane; i < 256; i += 64) mskw[i] = 0u;
    lds_wait();
    {
        const int nsel = (qb + 1) < 16 ? (qb + 1) : 16;
#pragma unroll
        for (int e2 = 0; e2 < 2; ++e2) { const int e = lane + 64 * e2, q = e >> 4, slot = e & 15;
            if (slot < nsel) { const int j = ((const unsigned char*)(C.ws + WS_IDX))[((size_t)(tq0 + q) * 2 + g) * 16 + slot]; atomicOr((unsigned*)(mskw + j), 1u << q); } }
    }
    lds_wait();
    h16x8 qf[2][2];
#pragma unroll
    for (int c = 0; c < 2; ++c)
#pragma unroll
        for (int ks = 0; ks < 2; ++ks) qf[c][ks] = *(const h16x8*)(proj + (size_t)(tq0 + 4 * c + qi) * PP + C_QN + (g * 4 + hd) * 64 + 32 * ks + 8 * fq);
    f32x4 O[2][4]; float m[2], l[2];
#pragma unroll
    for (int c = 0; c < 2; ++c) { m[c] = -INFINITY; l[c] = 0.f;
#pragma unroll
        for (int dt = 0; dt < 4; ++dt) O[c][dt] = (f32x4){0.f, 0.f, 0.f, 0.f}; }
    const float bfar = C.in[13][31 * 16 + g * 4 + hd];
    const int srow = C.tid >> 3, sch = C.tid & 7;
#pragma unroll 1
    for (int blk = 0; blk <= qb; ++blk) {
        const u32x4 kreg = *(const u32x4*)(proj + (size_t)(blk * 64 + srow) * PP + C_KS + g * 64 + sch * 8);
        const u32x4 vreg = *(const u32x4*)(vsT + (size_t)srow * S + blk * 64 + sch * 8);
        __syncthreads();
        *(LDSP u32x4*)(Kl + srow * SEL_ROWB + sch * 16) = kreg;
        *(LDSP u32x4*)(Vl + srow * SEL_ROWB + sch * 16) = vreg;
        __syncthreads();
        const unsigned mk = (unsigned)__builtin_amdgcn_readfirstlane((int)mskw[blk]);
        if (mk == 0u) continue;
        h16x8 kf[4][2];
#pragma unroll
        for (int T = 0; T < 4; ++T)
#pragma unroll
            for (int ks = 0; ks < 2; ++ks) kf[T][ks] = *(const LDSP h16x8*)(Kl + (16 * T + fr) * SEL_ROWB + 64 * ks + 16 * fq);
        h16x8 vf[4][2];
#pragma unroll
        for (int dt = 0; dt < 4; ++dt)
#pragma unroll
            for (int k2 = 0; k2 < 2; ++k2) { const LDSP unsigned char* vp = Vl + (16 * dt + fr) * SEL_ROWB + 64 * k2 + 8 * fq;
                vf[dt][k2] = cat44(*(const LDSP h16x4*)vp, *(const LDSP h16x4*)(vp + 32)); }
        const bool far = (tq0 - (blk * 64 + 63)) >= 790;
#pragma unroll
        for (int c = 0; c < 2; ++c) {
            if (((mk >> (4 * c)) & 15u) == 0u) continue;
            f32x4 Sx[4];
#pragma unroll
            for (int T = 0; T < 4; ++T) { f32x4 z = (f32x4){0.f, 0.f, 0.f, 0.f}; z = MFMA16(kf[T][0], qf[c][0], z); Sx[T] = MFMA16(kf[T][1], qf[c][1], z); }
            const int tq = tq0 + 4 * c + qi; const bool qsel = ((mk >> (4 * c + qi)) & 1u) != 0u;
            float tm = -INFINITY;
#pragma unroll
            for (int T = 0; T < 4; ++T)
#pragma unroll
                for (int r = 0; r < 4; ++r) { const int dist = tq - (blk * 64 + 16 * T + 4 * fq + r);
                    float b = bfar; if (!far) { const int dc = dist < 0 ? 0 : (dist > 1023 ? 1023 : dist); b = tabg[hd * SEL_TABH + dc]; }
                    const float s = (qsel && dist >= 0) ? Sx[T][r] * 0.125f + b : -INFINITY; Sx[T][r] = s; tm = fmaxf(tm, s); }
            tm = xmax4(tm);
            const float mn = fmaxf(m[c], tm), ms = (mn == -INFINITY) ? 0.f : mn;
            if (__builtin_amdgcn_ballot_w64(mn != m[c]) != 0ull) {
                const float alpha = __expf(m[c] - ms); l[c] *= alpha;
#pragma unroll
                for (int dt = 0; dt < 4; ++dt) O[c][dt] = O[c][dt] * alpha;
                m[c] = mn;
            }
            float ps = 0.f;
#pragma unroll
            for (int T = 0; T < 4; ++T)
#pragma unroll
                for (int r = 0; r < 4; ++r) { const float e = __expf(Sx[T][r] - ms); Sx[T][r] = e; ps += e; }
            l[c] += ps;
            const h16x8 p0 = pack_p(Sx[0], Sx[1]), p1 = pack_p(Sx[2], Sx[3]);
#pragma unroll
            for (int dt = 0; dt < 4; ++dt) { O[c][dt] = MFMA16(vf[dt][0], p0, O[c][dt]); O[c][dt] = MFMA16(vf[dt][1], p1, O[c][dt]); }
        }
    }
    const float* GS = (const float*)(C.ws + WS_GS); h16* oa = (h16*)(C.ws + WS_OA); const h16* ow = (const h16*)(C.ws + WS_OW);
#pragma unroll
    for (int c = 0; c < 2; ++c) {
        const int t = tq0 + 4 * c + qi; const float inv = 1.0f / fmaxf(xsum4(l[c]), 1e-30f);
        const float g0 = GS[(size_t)t * 24 + g * 12 + hd * 3 + 0], g1 = GS[(size_t)t * 24 + g * 12 + hd * 3 + 1], g2 = GS[(size_t)t * 24 + g * 12 + hd * 3 + 2];
        const size_t base = (size_t)t * 512 + (g * 4 + hd) * 64 + 4 * fq;
#pragma unroll
        for (int dt = 0; dt < 4; ++dt) { const h16x4 cv = *(const h16x4*)(oa + base + 16 * dt), wv = *(const h16x4*)(ow + base + 16 * dt); h16x4 o;
#pragma unroll
            for (int r = 0; r < 4; ++r) o[r] = (h16)(g0 * (float)cv[r] + g1 * (O[c][dt][r] * inv) + g2 * (float)wv[r]);
            *(h16x4*)(oa + base + 16 * dt) = o; }
    }
    __syncthreads();
}
__device__ __forceinline__ void phase4_mfma(Ctx& C) {
    LDSP unsigned char* Kl = C.lds; LDSP unsigned char* Vl = C.lds + 64 * SEL_ROWB;
    LDSP float* tab = (LDSP float*)(C.lds + 2 * 64 * SEL_ROWB);
    LDSP unsigned* msk = (LDSP unsigned*)(C.lds + 2 * 64 * SEL_ROWB + 33024);
    build_sel_table(C, tab);
    __syncthreads();
    for (int u = blockIdx.x; u < 512; u += gridDim.x) {
        const int qb = (u < 256) ? (u >> 1) : (255 - ((u - 256) >> 1)), g = u & 1;
        sel_wg_unit(C, qb, g, Kl, Vl, tab + g * 4 * SEL_TABH, msk + C.wave * 256);
    }
}

__device__ __forceinline__ void phase_rows1(Ctx& C) {
    const float* z = (const float*)(C.ws + WS_R0); h16* h1h = (h16*)(C.ws + WS_R1); float* rstd1 = (float*)(C.ws + WS_RSTD1);
    for (int m = C.gw; m < S; m += C.NGW) {
        const f32x4* zr = (const f32x4*)(z + (size_t)m * D) + C.lane; const f32x4* xr = (const f32x4*)(C.in[0] + (size_t)m * D) + C.lane; const f32x4* gr = (const f32x4*)C.in[2] + C.lane;
        f32x4 v[4]; float s = 0.f;
#pragma unroll
        for (int j = 0; j < 4; ++j) { v[j] = zr[64 * j]; s += (v[j].x * v[j].x + v[j].y * v[j].y) + (v[j].z * v[j].z + v[j].w * v[j].w); }
        const float rs = 1.0f / sqrtf(wave_sum(s) * (1.0f / D) + EPS); float s2 = 0.f;
#pragma unroll
        for (int j = 0; j < 4; ++j) { v[j] = xr[64 * j] + v[j] * rs * gr[64 * j]; s2 += (v[j].x * v[j].x + v[j].y * v[j].y) + (v[j].z * v[j].z + v[j].w * v[j].w); }
        s2 = wave_sum(s2);
        if (C.lane == 0) rstd1[m] = 1.0f / sqrtf(s2 * (1.0f / D) + EPS);
        f32x4* orow = (f32x4*)(C.out + (size_t)m * D) + C.lane; unsigned long long* o8 = (unsigned long long*)(h1h + (size_t)m * D) + C.lane;
#pragma unroll
        for (int j = 0; j < 4; ++j) { orow[64 * j] = v[j]; o8[64 * j] = (unsigned long long)pkh(v[j].x, v[j].y) | ((unsigned long long)pkh(v[j].z, v[j].w) << 32); }
    }
}
__device__ __forceinline__ void phase_rows2(Ctx& C) {
    const float* z = (const float*)(C.ws + WS_Z2);
    for (int m = C.gw; m < S; m += C.NGW) {
        const f32x4* zr = (const f32x4*)(z + (size_t)m * D) + C.lane; f32x4* orow = (f32x4*)(C.out + (size_t)m * D) + C.lane; const f32x4* gr = (const f32x4*)C.in[4] + C.lane;
        f32x4 v[4]; float s = 0.f;
#pragma unroll
        for (int j = 0; j < 4; ++j) { v[j] = zr[64 * j]; s += (v[j].x * v[j].x + v[j].y * v[j].y) + (v[j].z * v[j].z + v[j].w * v[j].w); }
        const float rs = 1.0f / sqrtf(wave_sum(s) * (1.0f / D) + EPS);
#pragma unroll
        for (int j = 0; j < 4; ++j) orow[64 * j] = orow[64 * j] + v[j] * rs * gr[64 * j];
    }
}

constexpr int NPHASE = 11;
__global__ void __launch_bounds__(NTHR, 2) fwd_kernel(Args args) {
    extern __shared__ __attribute__((aligned(16))) unsigned char lds_raw[];
    Ctx C;
    C.lds = (LDSP unsigned char*)lds_raw; C.tid = threadIdx.x; C.lane = C.tid & 63; C.wave = __builtin_amdgcn_readfirstlane(C.tid >> 6);
    C.gw = blockIdx.x * NWAVES + C.wave; C.NGW = gridDim.x * NWAVES;
#pragma unroll
    for (int i = 0; i < 19; ++i) C.in[i] = args.in[i];
    C.out = args.out; C.ws = args.ws;
    const int lo = args.ph_lo, hi = args.ph_hi;
    unsigned char* ws = args.ws;
#define IN(k) (lo <= (k) && (k) < hi)
#define SEAM(k) do { if (IN(k) && IN((k) + 1)) { if (args.coop) { cg::this_grid().sync(); } } } while (0)
    if (IN(0)) { phase_prologue(C); } SEAM(0);
    if (IN(1)) { pg8::Gemm g{(const h16*)(ws + WS_R1), (const h16*)(ws + WS_WIN), S, PP, D}; pg8::StaticOrder So; So.init(S, PP, (int)gridDim.x, (int)blockIdx.x);
        pg8::EpiProjF E{(h16*)(ws + WS_R0), (const float*)(ws + WS_RSTDX), (h16*)(ws + WS_VST), (h16*)(ws + WS_VWT), (h16*)(ws + WS_VBT)};
        pg8::gemm_phase<pg8::EpiProjF, pg8::StaticOrder, true, true>(C.lds, g, So, E); } SEAM(1);
    if (IN(2)) { phase_compress_naive(C); } SEAM(2);
    if (IN(3)) { __syncthreads();
#if USE_MFMA_P3
        phase3_mfma(C); __syncthreads();
#endif
#if !USE_MFMA_P3 || !USE_MFMA_CMP || !USE_MFMA_SWA
        phase_cmp_swa_naive(C);
#endif
    } SEAM(3);
    if (IN(4)) { __syncthreads();
#if USE_MFMA_P4
        phase4_mfma(C);
#else
        phase_selwin_naive(C);
#endif
    } SEAM(4);
    if (IN(5)) { pg8::StaticOrder So; So.init(S, D, (int)gridDim.x, (int)blockIdx.x);
        { pg8::Gemm g{(const h16*)(ws + WS_OA), (const h16*)(ws + WS_WUA), S, D, 512}; pg8::EpiUpF<0> E{(h16*)(ws + WS_R1), (const h16*)(ws + WS_R0) + C_GA};
          pg8::gemm_phase<pg8::EpiUpF<0>, pg8::StaticOrder, false, true>(C.lds, g, So, E); }
        { pg8::Gemm g{(const h16*)(ws + WS_OB), (const h16*)(ws + WS_WUB), S, D, 512}; pg8::EpiUpF<1> E{(h16*)(ws + WS_R1), (const h16*)(ws + WS_R0) + C_GB};
          pg8::gemm_phase<pg8::EpiUpF<1>, pg8::StaticOrder, false, true>(C.lds, g, So, E); } } SEAM(5);
    if (IN(6)) { pg8::Gemm g{(const h16*)(ws + WS_R1), (const h16*)(ws + WS_WOUT), S, D, D}; pg8::StaticOrder So; So.init(S, D, (int)gridDim.x, (int)blockIdx.x);
        pg8::EpiF32F E{(float*)(ws + WS_R0), D};
        pg8::gemm_phase<pg8::EpiF32F, pg8::StaticOrder, false, true>(C.lds, g, So, E); } SEAM(6);
    if (IN(7)) { phase_rows1(C); } SEAM(7);
    if (IN(8)) { pg8::Gemm g{(const h16*)(ws + WS_R1), (const h16*)(ws + WS_W1), S, FF, D}; pg8::StaticOrder So; So.init(S, FF, (int)gridDim.x, (int)blockIdx.x);
        pg8::EpiRelu2F E{(h16*)(ws + WS_R0), (const float*)(ws + WS_RSTD1)};
        pg8::gemm_phase<pg8::EpiRelu2F, pg8::StaticOrder, true, true>(C.lds, g, So, E); } SEAM(8);
    if (IN(9)) { pg8::Gemm g{(const h16*)(ws + WS_R0), (const h16*)(ws + WS_W2), S, D, FF}; pg8::StaticOrder So; So.init(S, D, (int)gridDim.x, (int)blockIdx.x);
        pg8::EpiF32F E{(float*)(ws + WS_Z2), D};
        pg8::gemm_phase<pg8::EpiF32F, pg8::StaticOrder, false, true>(C.lds, g, So, E); } SEAM(9);
    if (IN(10)) { phase_rows2(C); }
#undef IN
#undef SEAM
}

extern "C" void kernel_launch(void* const* d_in, const int* in_sizes, int n_in, void* d_out, int out_size, void* d_ws, size_t ws_size, hipStream_t stream) {
    static int grid = 0;
    if (grid == 0) {
        int dev = 0, cus = 0, per_cu = 0;
        hipGetDevice(&dev);
        hipDeviceGetAttribute(&cus, hipDeviceAttributeMultiprocessorCount, dev);
        hipFuncSetAttribute((const void*)fwd_kernel, hipFuncAttributeMaxDynamicSharedMemorySize, LDS_BYTES);
        hipOccupancyMaxActiveBlocksPerMultiprocessor(&per_cu, (const void*)fwd_kernel, NTHR, LDS_BYTES);
        if (per_cu < 1) { fprintf(stderr, "occupancy query says %d blocks/CU\n", per_cu); per_cu = 1; }
        grid = cus * 1;
        (void)hipGetLastError();
    }
    Args a{};
    for (int i = 0; i < 19; ++i) a.in[i] = (const float*)d_in[i];
    a.out = (float*)d_out; a.ws = (unsigned char*)d_ws;
#if N_LAUNCH_MODE == 1
    a.ph_lo = 0; a.ph_hi = NPHASE; a.coop = 1;
    void* kargs[] = {&a};
    hipError_t e = hipLaunchCooperativeKernel((const void*)fwd_kernel, dim3(grid), dim3(NTHR), kargs, LDS_BYTES, stream);
    if (e != hipSuccess) fprintf(stderr, "cooperative launch failed: %s (grid %d)\n", hipGetErrorString(e), grid);
#else
    for (int p = 0; p < NPHASE; ++p) {
        a.ph_lo = p; a.ph_hi = p + 1; a.coop = 0;
        hipLaunchKernelGGL(fwd_kernel, dim3(grid), dim3(NTHR), LDS_BYTES, stream, a);
    }
#endif
}
```

```cpp
#include <hip/hip_runtime.h>
#include <hip/hip_cooperative_groups.h>
#include <cstdio>
#include <cstdint>
namespace cg = cooperative_groups;

#ifndef REP3
#define REP3 0
#endif
#ifndef REP_MASK
#define REP_MASK 0
#endif
#ifndef N_LAUNCH_MODE
#define N_LAUNCH_MODE 1
#endif

#define LDSP __attribute__((address_space(3)))
typedef _Float16 h16;
typedef _Float16 h16x8 __attribute__((ext_vector_type(8)));
typedef _Float16 h16x4 __attribute__((ext_vector_type(4)));
typedef float f32x4 __attribute__((ext_vector_type(4)));
typedef unsigned u32x4 __attribute__((ext_vector_type(4)));

constexpr int S = 16384, D = 1024, FF = 4096, NIN = 4120;
constexpr int PP = 3328;
constexpr int C_QN = 0, C_KC = 512, C_VC = 640, C_QS = 768, C_GA = 1280, C_GB = 2304;
constexpr int NCMP = 1023;
constexpr float EPS = 1e-6f;
constexpr int NWAVES = 8, NTHR = 512;
constexpr int LDS_BYTES = 163840;

constexpr size_t MiB = 1u << 20;
constexpr size_t WS_CTL = 0;
constexpr size_t WS_WIN = 1 * MiB;
constexpr size_t WS_W1 = 9 * MiB;
constexpr size_t WS_W2 = 17 * MiB;
constexpr size_t WS_WOUT = 25 * MiB;
constexpr size_t WS_WUA = 27 * MiB;
constexpr size_t WS_WUB = 28 * MiB;
constexpr size_t WS_CW1K = 29 * MiB;
constexpr size_t WS_CW1V = 30 * MiB;
constexpr size_t WS_SMALL = 31 * MiB;
constexpr size_t WS_WG = WS_SMALL, WS_CW2K = WS_SMALL + 65536, WS_CW2V = WS_CW2K + 32768, WS_CBP = WS_CW2V + 32768;
constexpr size_t WS_R1 = 32 * MiB;
constexpr size_t WS_OA = 64 * MiB;
constexpr size_t WS_OB = 80 * MiB;
constexpr size_t WS_Z2 = 32 * MiB;
constexpr size_t WS_R0 = 96 * MiB;
constexpr size_t WS_KS = 200 * MiB, WS_KW = 204 * MiB, WS_KB = 208 * MiB;
constexpr size_t WS_VST = 224 * MiB;
constexpr size_t WS_VWT = 228 * MiB;
constexpr size_t WS_VBT = 232 * MiB;
constexpr size_t WS_KC = 236 * MiB;
constexpr size_t WS_VCR = WS_KC + 262144;
constexpr size_t WS_VCT = WS_VCR + 262144;
constexpr size_t WS_RSTDX = 237 * MiB;
constexpr size_t WS_RSTD1 = WS_RSTDX + 65536;
constexpr size_t WS_IDX = 238 * MiB;
constexpr size_t WS_GS = 238 * MiB + 524288;
constexpr size_t WS_OW = 240 * MiB;

struct Args { const float* in[19]; float* out; unsigned char* ws; int ph_lo, ph_hi, coop, pad; };

__device__ __forceinline__ float wave_sum(float v) {
#pragma unroll
    for (int o = 32; o >= 1; o >>= 1) v += __shfl_xor(v, o);
    return v;
}
__device__ __forceinline__ float wave_max(float v) {
#pragma unroll
    for (int o = 32; o >= 1; o >>= 1) v = fmaxf(v, __shfl_xor(v, o));
    return v;
}
__device__ __forceinline__ void lds_wait() { asm volatile("s_waitcnt lgkmcnt(0)" ::: "memory"); }
__device__ __forceinline__ unsigned pkh(float a, float b) { h16 x = (h16)a, y = (h16)b; return (unsigned)__builtin_bit_cast(unsigned short, x) | ((unsigned)__builtin_bit_cast(unsigned short, y) << 16); }
__device__ __forceinline__ float sigmoidf_(float x) { return 1.0f / (1.0f + __expf(-x)); }

struct Ctx {
    LDSP unsigned char* lds; int tid, lane, wave, gw, NGW, nowrite;
    const float* in[19]; float* out; unsigned char* ws;
};

namespace pg8 {
#define PG8_LAS __attribute__((address_space(3)))
typedef _Float16 bf16_t;
typedef _Float16 bf16x8 __attribute__((ext_vector_type(8)));
typedef float f32x4 __attribute__((ext_vector_type(4)));
typedef unsigned u32x4 __attribute__((ext_vector_type(4)));
constexpr int BM = 256, BK = 64, HALF = 128, HTB = HALF * BK * 2  , STAGE_BYTES = 8 * HTB, NXCD = 8, WGM = 8;

__host__ __device__ __forceinline__ int lds_byte(int r, int c) { const int st = (r >> 4) * 2 + (c >> 5), rr = r & 15, cc = c & 31, ob = rr * 64 + cc * 2; return st * 1024 + (ob ^ (((ob >> 9) & 1) << 5)); }
__host__ __device__ __forceinline__ void stage_rc(int b, int& R, int& C) { const int st = b / 1024, sb = b % 1024, swz = sb ^ (((sb >> 9) & 1) << 5); R = (st >> 1) * 16 + swz / 64; C = (st & 1) * 32 + (swz % 64) / 2; }
__host__ __device__ __forceinline__ int perm32(int rho) { const int n = rho >> 4, i = rho & 15; return 8 * (i >> 2) + 4 * n + (i & 3); }

struct Unit { int pm, pn; };
struct Gemm { const bf16_t* A; const bf16_t* Bt; int M, N, K; };

struct StaticOrder {
    int nM, nN, nwg, G, c;
    __host__ __device__ void init(int M, int N, int G_, int c_) { nM = M / BM; nN = N / BM; nwg = nM * nN; G = G_; c = c_; }
    __host__ __device__ bool next(int i, Unit& u) const {
        const long L = (long)i * G + c; if (L >= nwg) return false;
        int wgid = (int)L; { const int q = nwg / NXCD, r = nwg % NXCD, xcd = wgid % NXCD, off = wgid / NXCD; wgid = (xcd < r ? xcd * (q + 1) : r * (q + 1) + (xcd - r) * q) + off; }
        const int nig = WGM * nN, gid = wgid / nig, fm = gid * WGM, gsz = (nM - fm) < WGM ? (nM - fm) : WGM;
        u.pm = fm + ((wgid % nig) % gsz); u.pn = (wgid % nig) / gsz; return true;
    }
    __device__ __forceinline__ void a_ready(const Unit&) const {}
    __device__ __forceinline__ void done(const Unit&) const {}
};
template <class Epi, class Sched, bool ALIGN_EPI = false, bool SP2 = false>
__device__ __forceinline__ void gemm_phase(PG8_LAS unsigned char* lds, const Gemm g, const Sched& S, const Epi& E) {
    const int tid = threadIdx.x, wid = __builtin_amdgcn_readfirstlane(tid >> 6), lane = tid & 63, wr = wid >> 2, wc = wid & 3, fr = lane & 15, fq = lane >> 4;
    const int K = g.K, nt = K / BK;
    unsigned voffA[2], voffB[2];
#pragma unroll
    for (int i = 0; i < 2; ++i) { int R, C; stage_rc(tid * 16 + i * 8192, R, C); const int Rb = Epi::PERM ? ((R & ~31) + perm32(R & 31)) : R;
        voffA[i] = (unsigned)(R * K + C) * 2u; voffB[i] = (unsigned)(Rb * K + C) * 2u; }
    const size_t kstep = (size_t)(BK * 2);
    const size_t hstep = (size_t)HALF * K * 2;
    const size_t tstep = 2 * hstep;
    const unsigned ldsw = (unsigned)wid * 1024u;
    const int aoff = lds_byte(wr * 64 + fr, fq * 8), boff = lds_byte(wc * 32 + fr, fq * 8);
#define PG8_SA(b, h) (((b) * 2 + (h)) * HTB)
#define PG8_SB(b, h) ((4 + (b) * 2 + (h)) * HTB)
#define PG8_STAGE(bufoff, gbase, voff) do { _Pragma("unroll") for (int _i = 0; _i < 2; ++_i) \
        __builtin_amdgcn_global_load_lds((const unsigned*)((const char*)(gbase) + (voff)[_i]), (PG8_LAS unsigned*)(lds + (bufoff) + ldsw + _i * 8192), 16, 0, 0); } while (0)
#define PG8_LDA(dst, b, h) do { _Pragma("unroll") for (int m = 0; m < 4; ++m) _Pragma("unroll") for (int k = 0; k < 2; ++k) dst[m][k] = *(const PG8_LAS bf16x8*)(lds + PG8_SA(b, h) + aoff + m * 2048 + k * 1024); } while (0)
#define PG8_LDB(dst, b, h) do { _Pragma("unroll") for (int n = 0; n < 2; ++n) _Pragma("unroll") for (int k = 0; k < 2; ++k) dst[n][k] = *(const PG8_LAS bf16x8*)(lds + PG8_SB(b, h) + boff + n * 2048 + k * 1024); } while (0)
#define PG8_MMA(ai, bj, At, Bt) do { __builtin_amdgcn_s_setprio(1); _Pragma("unroll") for (int m = 0; m < 4; ++m) _Pragma("unroll") for (int n = 0; n < 2; ++n) _Pragma("unroll") for (int k = 0; k < 2; ++k) \
        acc[ai][bj][m][n] = __builtin_amdgcn_mfma_f32_16x16x32_f16(Bt[n][k], At[m][k], acc[ai][bj][m][n], 0, 0, 0); __builtin_amdgcn_s_setprio(0); } while (0)
#define PG8_WAIT_V(n) asm volatile("s_waitcnt vmcnt(" #n ")" ::: "memory")
#define PG8_WAIT_L(n) asm volatile("s_waitcnt lgkmcnt(" #n ")" ::: "memory")
#define PG8_BAR __builtin_amdgcn_s_barrier()
#define PG8_SCHED __builtin_amdgcn_sched_barrier(0)
    Unit cur, nxt; int ui = 0;
    if (!S.next(0, cur)) return;
    f32x4 acc[2][2][4][2];
#pragma unroll
    for (int a = 0; a < 2; ++a)
#pragma unroll
        for (int b = 0; b < 2; ++b)
#pragma unroll
            for (int m = 0; m < 4; ++m)
#pragma unroll
                for (int n = 0; n < 2; ++n) acc[a][b][m][n] = (f32x4){0.f, 0.f, 0.f, 0.f};
    bf16x8 At[4][2], B0[2][2], B1[2][2];
    const char* cA = (const char*)g.A + (size_t)cur.pm * tstep; const char* cB = (const char*)g.Bt + (size_t)cur.pn * tstep;
    S.a_ready(cur);
    if constexpr (SP2) {
        PG8_STAGE(PG8_SB(0, 0), cB, voffB); PG8_STAGE(PG8_SB(0, 1), cB + hstep, voffB); PG8_STAGE(PG8_SA(0, 0), cA, voffA); PG8_STAGE(PG8_SA(0, 1), cA + hstep, voffA);
        if (wr == 1) PG8_BAR;
        PG8_WAIT_V(2); PG8_BAR;
        PG8_STAGE(PG8_SB(1, 0), cB + kstep, voffB); PG8_STAGE(PG8_SA(1, 0), cA + kstep, voffA); PG8_STAGE(PG8_SB(1, 1), cB + hstep + kstep, voffB);
        PG8_WAIT_V(6); PG8_BAR;
    } else {
        PG8_STAGE(PG8_SB(0, 0), cB, voffB); PG8_STAGE(PG8_SA(0, 0), cA, voffA); PG8_STAGE(PG8_SB(0, 1), cB + hstep, voffB); PG8_STAGE(PG8_SA(0, 1), cA + hstep, voffA);
        if (wr == 1) PG8_BAR;
        PG8_WAIT_V(4); PG8_BAR;
        PG8_STAGE(PG8_SB(1, 0), cB + kstep, voffB); PG8_STAGE(PG8_SA(1, 0), cA + kstep, voffA); PG8_STAGE(PG8_SB(1, 1), cB + hstep + kstep, voffB);
        PG8_WAIT_V(6); PG8_BAR;
    }
    for (;;) {
        const bool has_next = S.next(ui + 1, nxt);
        const char* nA = has_next ? (const char*)g.A + (size_t)nxt.pm * tstep : cA; const char* nB = has_next ? (const char*)g.Bt + (size_t)nxt.pn * tstep : cB;
        for (int t = 0; t < nt; t += 2) {
            const bool last = (t == nt - 2);
            const char* a1 = cA + (size_t)(t + 1) * kstep;
            const char* a2 = last ? nA : cA + (size_t)(t + 2) * kstep; const char* b2 = last ? nB : cB + (size_t)(t + 2) * kstep;
            const char* a3 = a2 + kstep; const char* b3 = b2 + kstep;
            if (last && has_next) S.a_ready(nxt);
            if constexpr (SP2) {
            PG8_LDB(B0, 0, 0); PG8_LDB(B1, 0, 1); PG8_SCHED; PG8_LDA(At, 0, 0); PG8_STAGE(PG8_SA(1, 1), a1 + hstep, voffA);
            PG8_WAIT_V(8); PG8_WAIT_L(0); PG8_BAR; PG8_MMA(0, 0, At, B0); PG8_MMA(0, 1, At, B1); PG8_BAR; PG8_SCHED;
            PG8_LDA(At, 0, 1); PG8_STAGE(PG8_SB(0, 0), b2, voffB); PG8_STAGE(PG8_SB(0, 1), b2 + hstep, voffB); PG8_STAGE(PG8_SA(0, 0), a2, voffA);
            PG8_WAIT_V(8); PG8_WAIT_L(0); PG8_BAR; PG8_MMA(1, 0, At, B0); PG8_MMA(1, 1, At, B1); PG8_BAR; PG8_SCHED;
            PG8_LDB(B0, 1, 0); PG8_LDB(B1, 1, 1); PG8_SCHED; PG8_LDA(At, 1, 0); PG8_STAGE(PG8_SA(0, 1), a2 + hstep, voffA);
            PG8_WAIT_V(8); PG8_WAIT_L(0); PG8_BAR; PG8_MMA(0, 0, At, B0); PG8_MMA(0, 1, At, B1); PG8_BAR; PG8_SCHED;
            PG8_LDA(At, 1, 1); PG8_STAGE(PG8_SB(1, 0), b3, voffB); PG8_STAGE(PG8_SB(1, 1), b3 + hstep, voffB); PG8_STAGE(PG8_SA(1, 0), a3, voffA);
            PG8_WAIT_V(8); PG8_WAIT_L(0); PG8_BAR; PG8_MMA(1, 0, At, B0); PG8_MMA(1, 1, At, B1); PG8_BAR; PG8_SCHED;
            } else {
            PG8_LDB(B0, 0, 0); PG8_SCHED; PG8_LDA(At, 0, 0); PG8_STAGE(PG8_SA(1, 1), a1 + hstep, voffA);
            PG8_WAIT_L(8); PG8_BAR; PG8_WAIT_L(0); PG8_MMA(0, 0, At, B0); PG8_BAR; PG8_SCHED;
            PG8_LDB(B1, 0, 1); PG8_STAGE(PG8_SB(0, 0), b2, voffB);
            PG8_BAR; PG8_WAIT_L(0); PG8_MMA(0, 1, At, B1); PG8_BAR;
            PG8_LDA(At, 0, 1); PG8_STAGE(PG8_SA(0, 0), a2, voffA);
            PG8_BAR; PG8_WAIT_L(0); PG8_MMA(1, 0, At, B0); PG8_BAR; PG8_SCHED;
            PG8_STAGE(PG8_SB(0, 1), b2 + hstep, voffB);
            PG8_WAIT_V(6); PG8_BAR; PG8_MMA(1, 1, At, B1); PG8_BAR;
            PG8_LDB(B0, 1, 0); PG8_SCHED; PG8_LDA(At, 1, 0); PG8_STAGE(PG8_SA(0, 1), a2 + hstep, voffA);
            PG8_WAIT_L(8); PG8_BAR; PG8_WAIT_L(0); PG8_MMA(0, 0, At, B0); PG8_BAR; PG8_SCHED;
            PG8_LDB(B1, 1, 1); PG8_STAGE(PG8_SB(1, 0), b3, voffB);
            PG8_BAR; PG8_WAIT_L(0); PG8_MMA(0, 1, At, B1); PG8_BAR;
            PG8_LDA(At, 1, 1); PG8_STAGE(PG8_SA(1, 0), a3, voffA);
            PG8_BAR; PG8_WAIT_L(0); PG8_MMA(1, 0, At, B0); PG8_BAR; PG8_SCHED;
            PG8_STAGE(PG8_SB(1, 1), b3 + hstep, voffB);
            PG8_WAIT_V(6); PG8_BAR; PG8_MMA(1, 1, At, B1); PG8_BAR;
            }
        }
        if constexpr (ALIGN_EPI) { if (wr == 0) PG8_BAR; }
        if constexpr (!Epi::AFTER_DRAIN) { E(acc, cur, wr, wc, fr, fq); S.done(cur); }
        if (!has_next) break;
#pragma unroll
        for (int a = 0; a < 2; ++a)
#pragma unroll
            for (int b = 0; b < 2; ++b)
#pragma unroll
                for (int m = 0; m < 4; ++m)
#pragma unroll
                    for (int n = 0; n < 2; ++n) acc[a][b][m][n] = (f32x4){0.f, 0.f, 0.f, 0.f};
        cur = nxt; cA = nA; cB = nB; ++ui;
        if constexpr (ALIGN_EPI) { if (wr == 1) PG8_BAR; }
    }
    PG8_WAIT_V(0);
    if constexpr (!ALIGN_EPI) { if (wr == 0) PG8_BAR; }
    PG8_BAR;
    if constexpr (Epi::AFTER_DRAIN) { E.fused(acc, cur, wr, wc, fr, fq, lds, wid, lane); S.done(cur); }
#undef PG8_SA
#undef PG8_SB
#undef PG8_STAGE
#undef PG8_LDA
#undef PG8_LDB
#undef PG8_MMA
#undef PG8_WAIT_V
#undef PG8_WAIT_L
#undef PG8_BAR
#undef PG8_SCHED
}
}

namespace pg8 {
__device__ __forceinline__ u32x4 pack8(const f32x4 v0, const f32x4 v1) { u32x4 w; w.x = pkh(v0[0], v0[1]); w.y = pkh(v0[2], v0[3]); w.z = pkh(v1[0], v1[1]); w.w = pkh(v1[2], v1[3]); return w; }
struct EpiProjF {
    static constexpr bool PERM = true, AFTER_DRAIN = false;
    h16* proj; const float* rstd; unsigned char* ws;
    __device__ __forceinline__ void operator()(const f32x4 (&acc)[2][2][4][2], const Unit& u, int wr, int wc, int fr, int fq) const {
        const int row0 = u.pm * BM + wr * 64 + fr, c = wc * 32 + 8 * fq;
#pragma unroll
        for (int bj = 0; bj < 2; ++bj) {
            const int hb = u.pn * 2 + bj;
            int mode = 0, pcol = 0; size_t off = 0;
            if (hb < 6) pcol = hb * 128;
            else if (hb == 6) { mode = 1; off = WS_KS; } else if (hb == 7) { mode = 2; off = WS_VST; }
            else if (hb == 8) { mode = 1; off = WS_KW; } else if (hb == 9) { mode = 2; off = WS_VWT; }
            else if (hb < 14) pcol = 768 + (hb - 10) * 128;
            else if (hb == 14) { mode = 1; off = WS_KB; } else if (hb == 15) { mode = 2; off = WS_VBT; }
            else pcol = 1280 + (hb - 16) * 128;
#pragma unroll
            for (int ai = 0; ai < 2; ++ai)
#pragma unroll
                for (int m = 0; m < 4; ++m) { const int row = row0 + ai * HALF + m * 16; const float rs = rstd[row];
                    const f32x4 v0 = acc[ai][bj][m][0] * rs, v1 = acc[ai][bj][m][1] * rs;
                    if (mode == 0) *(u32x4*)(proj + (size_t)row * PP + pcol + c) = pack8(v0, v1);
                    else if (mode == 1) *(u32x4*)((h16*)(ws + off) + ((size_t)(c >> 6) * S + row) * 64 + (c & 63)) = pack8(v0, v1);
                    else { h16* q = (h16*)(ws + off) + ((size_t)(((c >> 6) * (S / 64) + (row >> 6)) * 64 + (c & 63))) * 64 + (row & 63);
#pragma unroll
                        for (int e = 0; e < 4; ++e) { q[e * 64] = (h16)v0[e]; q[(4 + e) * 64] = (h16)v1[e]; } } }
        }
    }
};
struct EpiRelu2F {
    static constexpr bool PERM = true, AFTER_DRAIN = false;
    h16* a; const float* rstd;
    __device__ __forceinline__ void operator()(const f32x4 (&acc)[2][2][4][2], const Unit& u, int wr, int wc, int fr, int fq) const {
        const int row0 = u.pm * BM + wr * 64 + fr, col0 = u.pn * BM + wc * 32 + 8 * fq;
#pragma unroll
        for (int ai = 0; ai < 2; ++ai)
#pragma unroll
            for (int m = 0; m < 4; ++m) { const int row = row0 + ai * HALF + m * 16; const float rs = rstd[row]; h16* rowp = a + (size_t)row * FF + col0;
#pragma unroll
                for (int bj = 0; bj < 2; ++bj) { f32x4 v0 = acc[ai][bj][m][0] * rs, v1 = acc[ai][bj][m][1] * rs;
#pragma unroll
                    for (int e = 0; e < 4; ++e) { const float p = fmaxf(v0[e], 0.f), q = fmaxf(v1[e], 0.f); v0[e] = p * p; v1[e] = q * q; }
                    *(u32x4*)(rowp + bj * HALF) = pack8(v0, v1); } }
    }
};
template <int SECOND> struct EpiUpF {
    static constexpr bool PERM = true, AFTER_DRAIN = false;
    h16* y; const h16* gate;
    __device__ __forceinline__ void operator()(const f32x4 (&acc)[2][2][4][2], const Unit& u, int wr, int wc, int fr, int fq) const {
        const int row0 = u.pm * BM + wr * 64 + fr, col0 = u.pn * BM + wc * 32 + 8 * fq;
#pragma unroll
        for (int ai = 0; ai < 2; ++ai)
#pragma unroll
            for (int m = 0; m < 4; ++m) { const int row = row0 + ai * HALF + m * 16; h16* rowp = y + (size_t)row * D + col0; const h16* gp = gate + (size_t)row * PP + col0;
#pragma unroll
                for (int bj = 0; bj < 2; ++bj) { const h16x8 gv = *(const h16x8*)(gp + bj * HALF); f32x4 v0 = acc[ai][bj][m][0], v1 = acc[ai][bj][m][1];
                    h16x8 old; if (SECOND) old = *(const h16x8*)(rowp + bj * HALF);
#pragma unroll
                    for (int e = 0; e < 4; ++e) { v0[e] *= sigmoidf_((float)gv[e]); v1[e] *= sigmoidf_((float)gv[4 + e]); if (SECOND) { v0[e] += (float)old[e]; v1[e] += (float)old[4 + e]; } }
                    *(u32x4*)(rowp + bj * HALF) = pack8(v0, v1); } }
    }
};
struct EpiF32F {
    static constexpr bool PERM = false, AFTER_DRAIN = false;
    float* z; int ldz;
    __device__ __forceinline__ void operator()(const f32x4 (&acc)[2][2][4][2], const Unit& u, int wr, int wc, int fr, int fq) const {
        const int row0 = u.pm * BM + wr * 64 + fr, col0 = u.pn * BM + wc * 32 + 4 * fq;
#pragma unroll
        for (int ai = 0; ai < 2; ++ai)
#pragma unroll
            for (int m = 0; m < 4; ++m) { float* rowp = z + (size_t)(row0 + ai * HALF + m * 16) * ldz + col0;
#pragma unroll
                for (int bj = 0; bj < 2; ++bj)
#pragma unroll
                    for (int n = 0; n < 2; ++n) *(f32x4*)(rowp + bj * HALF + n * 16) = acc[ai][bj][m][n]; }
    }
};
}

__device__ __forceinline__ void transpose_item(const float* W, int ldw, int col0, const float* scale, int K, h16* WT, int item, int nblk, LDSP float* scr, int lane) {
    const int kb = item / nblk, nb = item % nblk, k0 = 64 * kb, n0 = 32 * nb;
#pragma unroll 8
    for (int i = 0; i < 32; ++i) { const int kk = 2 * i + (lane >> 5); float v = W[(size_t)(k0 + kk) * ldw + col0 + n0 + (lane & 31)]; if (scale) v *= scale[k0 + kk]; scr[kk * 33 + (lane & 31)] = v; }
    lds_wait();
    const int c = lane & 7;
#pragma unroll
    for (int j = 0; j < 4; ++j) { const int n = (lane >> 3) + 8 * j; const LDSP float* s = scr + (8 * c) * 33 + n;
        u32x4 o; o.x = pkh(s[0 * 33], s[1 * 33]); o.y = pkh(s[2 * 33], s[3 * 33]); o.z = pkh(s[4 * 33], s[5 * 33]); o.w = pkh(s[6 * 33], s[7 * 33]);
        *(u32x4*)(WT + (size_t)(n0 + n) * K + k0 + 8 * c) = o; }
    lds_wait();
}

__device__ __forceinline__ void phase_prologue(Ctx& C) {
    LDSP float* scr = (LDSP float*)(C.lds + C.wave * 16384);
    const float* w_in = C.in[5];
    constexpr int I_WIN_A = 16 * 40, I_WIN_B = 16 * 88, I_WG = 16, I_UP = 8 * 32, I_OUT = 16 * 32, I_W1 = 16 * 128, I_W2 = 64 * 32, I_C1 = 32 * 8, I_C2 = 4 * 2;
    constexpr int NITEMS = I_WIN_A + I_WIN_B + I_WG + 2 * I_UP + I_OUT + I_W1 + I_W2 + 2 * I_C1 + 2 * I_C2;
    for (int it = C.gw; it < NITEMS; it += C.NGW) {
        int r = it;
        if (r < I_WIN_A) { transpose_item(w_in, NIN, 0, C.in[1], D, (h16*)(C.ws + WS_WIN), r, 40, scr, C.lane); continue; } r -= I_WIN_A;
        if (r < I_WIN_B) { transpose_item(w_in, NIN, 1304, C.in[1], D, (h16*)(C.ws + WS_WIN) + (size_t)1280 * D, r, 88, scr, C.lane); continue; } r -= I_WIN_B;
        if (r < I_WG) { transpose_item(w_in, NIN, 1280, C.in[1], D, (h16*)(C.ws + WS_WG), r, 1, scr, C.lane); continue; } r -= I_WG;
        if (r < I_UP) { transpose_item(C.in[14], D, 0, nullptr, 512, (h16*)(C.ws + WS_WUA), r, 32, scr, C.lane); continue; } r -= I_UP;
        if (r < I_UP) { transpose_item(C.in[15], D, 0, nullptr, 512, (h16*)(C.ws + WS_WUB), r, 32, scr, C.lane); continue; } r -= I_UP;
        if (r < I_OUT) { transpose_item(C.in[16], D, 0, nullptr, D, (h16*)(C.ws + WS_WOUT), r, 32, scr, C.lane); continue; } r -= I_OUT;
        if (r < I_W1) { transpose_item(C.in[17], FF, 0, C.in[3], D, (h16*)(C.ws + WS_W1), r, 128, scr, C.lane); continue; } r -= I_W1;
        if (r < I_W2) { transpose_item(C.in[18], D, 0, nullptr, FF, (h16*)(C.ws + WS_W2), r, 32, scr, C.lane); continue; } r -= I_W2;
        if (r < I_C1) { transpose_item(C.in[7], 256, 0, nullptr, 2048, (h16*)(C.ws + WS_CW1K), r, 8, scr, C.lane); continue; } r -= I_C1;
        if (r < I_C1) { transpose_item(C.in[10], 256, 0, nullptr, 2048, (h16*)(C.ws + WS_CW1V), r, 8, scr, C.lane); continue; } r -= I_C1;
        if (r < I_C2) { transpose_item(C.in[8], 64, 0, nullptr, 256, (h16*)(C.ws + WS_CW2K), r, 2, scr, C.lane); continue; } r -= I_C2;
        transpose_item(C.in[11], 64, 0, nullptr, 256, (h16*)(C.ws + WS_CW2V), r, 2, scr, C.lane);
    }
    for (int u = C.gw; u < 16 * 2 * 4; u += C.NGW) {
        const int s = u >> 3, kv = (u >> 2) & 1, nb = u & 3, n = nb * 64 + C.lane;
        const float* pos = C.in[kv ? 9 : 6]; const float* w1 = C.in[kv ? 10 : 7];
        float acc = 0.f;
        for (int k = s * 128; k < s * 128 + 128; ++k) acc += pos[k] * w1[(size_t)k * 256 + n];
        ((float*)(C.ws + WS_CBP))[(s * 2 + kv) * 256 + n] = acc;
    }
    h16* xh = (h16*)(C.ws + WS_R1); float* rstdx = (float*)(C.ws + WS_RSTDX);
    for (int m = C.gw; m < S; m += C.NGW) {
        const f32x4* xr = (const f32x4*)(C.in[0] + (size_t)m * D) + C.lane;
        f32x4 v[4]; float s = 0.f;
#pragma unroll
        for (int j = 0; j < 4; ++j) { v[j] = xr[64 * j]; s += (v[j].x * v[j].x + v[j].y * v[j].y) + (v[j].z * v[j].z + v[j].w * v[j].w); }
        s = wave_sum(s);
        if (C.lane == 0) rstdx[m] = 1.0f / sqrtf(s * (1.0f / D) + EPS);
        unsigned long long* o8 = (unsigned long long*)(xh + (size_t)m * D) + C.lane;
#pragma unroll
        for (int j = 0; j < 4; ++j) o8[64 * j] = (unsigned long long)pkh(v[j].x, v[j].y) | ((unsigned long long)pkh(v[j].z, v[j].w) << 32);
    }
}

#define MFMA16(a, b, c) __builtin_amdgcn_mfma_f32_16x16x32_f16((a), (b), (c), 0, 0, 0)
__device__ __forceinline__ h16x8 pack_p(const f32x4 a, const f32x4 b) {
    h16x8 r; r[0] = (h16)a[0]; r[1] = (h16)a[1]; r[2] = (h16)a[2]; r[3] = (h16)a[3]; r[4] = (h16)b[0]; r[5] = (h16)b[1]; r[6] = (h16)b[2]; r[7] = (h16)b[3]; return r;
}
__device__ __forceinline__ h16x8 cat44(const h16x4 a, const h16x4 b) { h16x8 r; r[0] = a[0]; r[1] = a[1]; r[2] = a[2]; r[3] = a[3]; r[4] = b[0]; r[5] = b[1]; r[6] = b[2]; r[7] = b[3]; return r; }
__device__ __forceinline__ float xmax4(float v) {
    auto r = __builtin_amdgcn_permlane32_swap(__float_as_uint(v), __float_as_uint(v), false, false);
    v = fmaxf(__uint_as_float(r[0]), __uint_as_float(r[1]));
    auto q = __builtin_amdgcn_permlane16_swap(__float_as_uint(v), __float_as_uint(v), false, false);
    return fmaxf(__uint_as_float(q[0]), __uint_as_float(q[1]));
}
__device__ __forceinline__ float xsum4(float v) {
    auto r = __builtin_amdgcn_permlane32_swap(__float_as_uint(v), __float_as_uint(v), false, false);
    v = __uint_as_float(r[0]) + __uint_as_float(r[1]);
    auto q = __builtin_amdgcn_permlane16_swap(__float_as_uint(v), __float_as_uint(v), false, false);
    return __uint_as_float(q[0]) + __uint_as_float(q[1]);
}
__device__ __forceinline__ unsigned wave_umax(unsigned v) {
    v = max(v, (unsigned)__builtin_amdgcn_update_dpp(0, (int)v, 0x111, 0xf, 0xf, true));
    v = max(v, (unsigned)__builtin_amdgcn_update_dpp(0, (int)v, 0x112, 0xf, 0xf, true));
    v = max(v, (unsigned)__builtin_amdgcn_update_dpp(0, (int)v, 0x114, 0xf, 0xf, true));
    v = max(v, (unsigned)__builtin_amdgcn_update_dpp(0, (int)v, 0x118, 0xf, 0xf, true));
    v = max(v, (unsigned)__builtin_amdgcn_update_dpp(0, (int)v, 0x142, 0xa, 0xf, true));
    v = max(v, (unsigned)__builtin_amdgcn_update_dpp(0, (int)v, 0x143, 0xc, 0xf, true));
    return (unsigned)__builtin_amdgcn_readlane((int)v, 63);
}
__device__ __forceinline__ int t5_bucket(int d) {
    if (d < 16) return d;
    const float x = (float)d / 16.0f; const int l = 16 + (int)(logf(x) / 4.158883083359672f * 16.0f); return l < 31 ? l : 31;
}
__device__ __forceinline__ void build_band_table(Ctx& C, LDSP float* tab, int NB, int headcol0) {
    for (int i = C.tid; i < NB * 4; i += NTHR) tab[i] = C.in[13][t5_bucket(i >> 2) * 16 + headcol0 + (i & 3)];
}
__device__ __forceinline__ const h16* vt_addr(const h16* VTg, int d, int key) { return VTg + ((size_t)((key >> 6) * 64 + d)) * 64 + (key & 63); }

template <int MODE>
__device__ __forceinline__ void band_unit(Ctx& C, int t0, int g, const LDSP float* tab, int NBT, h16* outp) {
    constexpr int W = (MODE == 2) ? 512 : 128, NPAIR = W / 32 + 1;
    const int lane = C.lane, fr = lane & 15, fq = lane >> 4;
    const h16* proj = (const h16*)(C.ws + WS_R0);
    const int qcol = (MODE == 2 ? C_QN : C_QS) + g * 256;
    const h16* Kg = (const h16*)(C.ws + (MODE == 2 ? WS_KW : WS_KB)) + (size_t)g * S * 64;
    const h16* VTg = (const h16*)(C.ws + (MODE == 2 ? WS_VWT : WS_VBT)) + (size_t)g * S * 64;
    h16x8 qf[4][2];
#pragma unroll
    for (int c = 0; c < 4; ++c)
#pragma unroll
        for (int ks = 0; ks < 2; ++ks) qf[c][ks] = *(const h16x8*)(proj + (size_t)(t0 + fr) * PP + qcol + c * 64 + 32 * ks + 8 * fq);
    f32x4 O[4][4]; float m[4], l[4];
#pragma unroll
    for (int c = 0; c < 4; ++c) {
#pragma unroll
        for (int dt = 0; dt < 4; ++dt) O[c][dt] = (f32x4){0.f, 0.f, 0.f, 0.f};
        if (MODE == 3) { m[c] = C.in[12][g * 4 + c]; l[c] = (fq == 0) ? 1.0f : 0.0f; } else { m[c] = -INFINITY; l[c] = 0.f; }
    }
    const int kbase = t0 + 16 - 32 * NPAIR;
    int p0 = 0; while (kbase + 32 * p0 + 32 <= 0) ++p0;
    h16x8 kf[2][2];
#define BAND_LOADK(KF, k0_) do { const int k0__ = (k0_); \
        _Pragma("unroll") for (int T = 0; T < 2; ++T) { int key = k0__ + 16 * T + fr; key = key < 0 ? 0 : key; \
            _Pragma("unroll") for (int ks = 0; ks < 2; ++ks) KF[T][ks] = *(const h16x8*)(Kg + (size_t)key * 64 + 32 * ks + 8 * fq); } } while (0)
#define BAND_LOADV(VA, k0_) do { const int k0__ = (k0_); int ka = k0__ + 4 * fq, kb = k0__ + 16 + 4 * fq; ka = ka < 0 ? 0 : ka; kb = kb < 0 ? 0 : kb; \
        _Pragma("unroll") for (int dt = 0; dt < 4; ++dt) { VA[dt][0] = *(const h16x4*)vt_addr(VTg, 16 * dt + fr, ka); VA[dt][1] = *(const h16x4*)vt_addr(VTg, 16 * dt + fr, kb); } } while (0)
    BAND_LOADK(kf, kbase + 32 * p0);
#pragma unroll 1
    for (int p = p0; p < NPAIR; ++p) {
        const int k0 = kbase + 32 * p;
        h16x8 kfn[2][2]; h16x4 va[4][2];
        BAND_LOADV(va, k0);
        { const int pn = (p + 1 < NPAIR) ? p + 1 : p; BAND_LOADK(kfn, kbase + 32 * pn); }
        f32x4 Sx[4][2];
#pragma unroll
        for (int c = 0; c < 4; ++c)
#pragma unroll
            for (int T = 0; T < 2; ++T) { f32x4 z = (f32x4){0.f, 0.f, 0.f, 0.f}; z = MFMA16(kf[T][0], qf[c][0], z); Sx[c][T] = MFMA16(kf[T][1], qf[c][1], z); }
#pragma unroll
        for (int T = 0; T < 2; ++T)
#pragma unroll
            for (int r = 0; r < 4; ++r) {
                const int key = k0 + 16 * T + 4 * fq + r, dist = t0 + fr - key;
                const bool valid = (dist >= 0) && (dist < W) && (key >= 0);
                const int dc = dist < 0 ? 0 : (dist > NBT - 1 ? NBT - 1 : dist);
                const f32x4 b4 = *(const LDSP f32x4*)(tab + dc * 4);
#pragma unroll
                for (int c = 0; c < 4; ++c) Sx[c][T][r] = valid ? Sx[c][T][r] * 0.125f + b4[c] : -INFINITY;
            }
        h16x8 pf[4];
#pragma unroll
        for (int c = 0; c < 4; ++c) {
            float tm = fmaxf(fmaxf(fmaxf(Sx[c][0][0], Sx[c][0][1]), fmaxf(Sx[c][0][2], Sx[c][0][3])), fmaxf(fmaxf(Sx[c][1][0], Sx[c][1][1]), fmaxf(Sx[c][1][2], Sx[c][1][3])));
            tm = xmax4(tm);
            const float mn = fmaxf(m[c], tm), ms = (mn == -INFINITY) ? 0.f : mn;
            if (__builtin_amdgcn_ballot_w64(mn != m[c]) != 0ull) {
                const float alpha = __expf(m[c] - ms);
                l[c] *= alpha;
#pragma unroll
                for (int dt = 0; dt < 4; ++dt) O[c][dt] = O[c][dt] * alpha;
                m[c] = mn;
            }
            float ps = 0.f;
#pragma unroll
            for (int T = 0; T < 2; ++T)
#pragma unroll
                for (int r = 0; r < 4; ++r) { const float e = __expf(Sx[c][T][r] - ms); Sx[c][T][r] = e; ps += e; }
            l[c] += ps;
            pf[c] = pack_p(Sx[c][0], Sx[c][1]);
        }
#pragma unroll
        for (int dt = 0; dt < 4; ++dt) { const h16x8 vf = cat44(va[dt][0], va[dt][1]);
#pragma unroll
            for (int c = 0; c < 4; ++c) O[c][dt] = MFMA16(vf, pf[c], O[c][dt]); }
#pragma unroll
        for (int T = 0; T < 2; ++T)
#pragma unroll
            for (int ks = 0; ks < 2; ++ks) kf[T][ks] = kfn[T][ks];
    }
#undef BAND_LOADK
#undef BAND_LOADV
#pragma unroll
    for (int c = 0; c < 4; ++c) {
        const float inv = 1.0f / fmaxf(xsum4(l[c]), 1e-30f);
        h16* op = outp + (size_t)(t0 + fr) * 512 + (g * 4 + c) * 64 + 4 * fq;
#pragma unroll
        for (int dt = 0; dt < 4; ++dt) { const f32x4 v = O[c][dt] * inv; h16x4 hv; hv[0] = (h16)v[0]; hv[1] = (h16)v[1]; hv[2] = (h16)v[2]; hv[3] = (h16)v[3]; *(h16x4*)(op + 16 * dt) = hv; }
    }
}

__device__ __forceinline__ void cmp_unit(Ctx& C, int t0, int g, LDSP float* psl  ) {
    const int lane = C.lane, fr = lane & 15, fq = lane >> 4;
    const h16* proj = (const h16*)(C.ws + WS_R0);
    const h16* Kc = (const h16*)(C.ws + WS_KC) + (size_t)g * 1024 * 64; const h16* VcT = (const h16*)(C.ws + WS_VCT) + (size_t)g * 1024 * 64;
    h16x8 qf[4][2];
#pragma unroll
    for (int c = 0; c < 4; ++c)
#pragma unroll
        for (int ks = 0; ks < 2; ++ks) qf[c][ks] = *(const h16x8*)(proj + (size_t)(t0 + fr) * PP + C_QN + g * 256 + c * 64 + 32 * ks + 8 * fq);
    const int tl = t0 + 15, nmax = (tl >= 31) ? (((tl - 31) >> 4) + 1) : 0, npair = (nmax + 31) >> 5;
    const int tq = t0 + fr, nv = (tq >= 31) ? (((tq - 31) >> 4) + 1) : 0;
    float m[4], l[4];
#pragma unroll
    for (int c = 0; c < 4; ++c) { m[c] = -INFINITY; l[c] = 0.f; }
#define CMP_LOADK(KF, k0_) do { _Pragma("unroll") for (int T = 0; T < 2; ++T) { int n = (k0_) + 16 * T + fr; n = n > 1022 ? 1022 : n; \
        _Pragma("unroll") for (int ks = 0; ks < 2; ++ks) KF[T][ks] = *(const h16x8*)(Kc + (size_t)n * 64 + 32 * ks + 8 * fq); } } while (0)
    {
        h16x8 kf[2][2]; CMP_LOADK(kf, 0);
#pragma unroll 1
        for (int p = 0; p < npair; ++p) {
            const int k0 = 32 * p;
            h16x8 kfn[2][2]; CMP_LOADK(kfn, (p + 1 < npair) ? k0 + 32 : k0);
#pragma unroll
            for (int c = 0; c < 4; ++c) {
                f32x4 s0 = (f32x4){0.f, 0.f, 0.f, 0.f}, s1 = s0;
                s0 = MFMA16(kf[0][0], qf[c][0], s0); s0 = MFMA16(kf[0][1], qf[c][1], s0);
                s1 = MFMA16(kf[1][0], qf[c][0], s1); s1 = MFMA16(kf[1][1], qf[c][1], s1);
                float tm = -INFINITY;
#pragma unroll
                for (int r = 0; r < 4; ++r) { const int n0 = k0 + 4 * fq + r; s0[r] = (n0 < nv) ? s0[r] * 0.125f : -INFINITY; s1[r] = (n0 + 16 < nv) ? s1[r] * 0.125f : -INFINITY; tm = fmaxf(tm, fmaxf(s0[r], s1[r])); }
                tm = xmax4(tm);
                const float mn = fmaxf(m[c], tm), ms = (mn == -INFINITY) ? 0.f : mn;
                float ps = 0.f;
#pragma unroll
                for (int r = 0; r < 4; ++r) ps += __expf(s0[r] - ms) + __expf(s1[r] - ms);
                l[c] = l[c] * __expf(m[c] - ms) + ps; m[c] = mn;
            }
#pragma unroll
            for (int T = 0; T < 2; ++T)
#pragma unroll
                for (int ks = 0; ks < 2; ++ks) kf[T][ks] = kfn[T][ks];
        }
    }
    float inv[4], msf[4];
#pragma unroll
    for (int c = 0; c < 4; ++c) { inv[c] = 1.0f / fmaxf(xsum4(l[c]), 1e-30f); msf[c] = (m[c] == -INFINITY) ? 0.f : m[c]; }
    for (int i = lane; i < 16 * 260; i += 64) psl[i] = 0.f;
    f32x4 O[4][4];
#pragma unroll
    for (int c = 0; c < 4; ++c)
#pragma unroll
        for (int dt = 0; dt < 4; ++dt) O[c][dt] = (f32x4){0.f, 0.f, 0.f, 0.f};
    {
        float carry = 0.f;
        h16x8 kf[2][2];
#define CMP_LOADV(VA, k0_) do { _Pragma("unroll") for (int dt = 0; dt < 4; ++dt) { VA[dt][0] = *(const h16x4*)vt_addr(VcT, 16 * dt + fr, (k0_) + 4 * fq); VA[dt][1] = *(const h16x4*)vt_addr(VcT, 16 * dt + fr, (k0_) + 16 + 4 * fq); } } while (0)
        CMP_LOADK(kf, 0);
#pragma unroll 1
        for (int p = 0; p < npair; ++p) {
            const int k0 = 32 * p;
            h16x8 kfn[2][2]; h16x4 va[4][2];
            CMP_LOADV(va, k0);
            CMP_LOADK(kfn, (p + 1 < npair) ? k0 + 32 : k0);
            f32x4 pg0 = (f32x4){0.f, 0.f, 0.f, 0.f}, pg1 = pg0; h16x8 pf[4];
#pragma unroll
            for (int c = 0; c < 4; ++c) {
                f32x4 s0 = (f32x4){0.f, 0.f, 0.f, 0.f}, s1 = s0;
                s0 = MFMA16(kf[0][0], qf[c][0], s0); s0 = MFMA16(kf[0][1], qf[c][1], s0);
                s1 = MFMA16(kf[1][0], qf[c][0], s1); s1 = MFMA16(kf[1][1], qf[c][1], s1);
#pragma unroll
                for (int r = 0; r < 4; ++r) { const int n0 = k0 + 4 * fq + r;
                    s0[r] = (n0 < nv) ? __expf(s0[r] * 0.125f - msf[c]) * inv[c] : 0.f; s1[r] = (n0 + 16 < nv) ? __expf(s1[r] * 0.125f - msf[c]) * inv[c] : 0.f; }
                pg0 += s0; pg1 += s1; pf[c] = pack_p(s0, s1);
            }
            {
                const float A0 = (pg0[0] + pg0[1]) + (pg0[2] + pg0[3]), A1 = (pg1[0] + pg1[1]) + (pg1[2] + pg1[3]);
                const float X0 = __shfl(pg0[3], (lane - 16) & 63), X1 = __shfl(pg1[3], (lane - 16) & 63);
                LDSP float* pr = psl + fr * 260 + 8 * p + fq;
                pr[0] = A0 + (fq > 0 ? X0 : carry); pr[4] = A1 + (fq > 0 ? X1 : X0); carry = X1;
            }
#pragma unroll
            for (int dt = 0; dt < 4; ++dt) { const h16x8 vf = cat44(va[dt][0], va[dt][1]);
#pragma unroll
                for (int c = 0; c < 4; ++c) O[c][dt] = MFMA16(vf, pf[c], O[c][dt]); }
#pragma unroll
            for (int T = 0; T < 2; ++T)
#pragma unroll
                for (int ks = 0; ks < 2; ++ks) kf[T][ks] = kfn[T][ks];
        }
        if (fq == 0 && npair > 0 && 8 * npair < 260) psl[fr * 260 + 8 * npair] = carry;
#undef CMP_LOADV
    }
#undef CMP_LOADK
    h16* oa = (h16*)(C.ws + WS_OA);
#pragma unroll
    for (int c = 0; c < 4; ++c) { h16* op = oa + (size_t)(t0 + fr) * 512 + (g * 4 + c) * 64 + 4 * fq;
#pragma unroll
        for (int dt = 0; dt < 4; ++dt) { const f32x4 v = O[c][dt]; h16x4 hv; hv[0] = (h16)v[0]; hv[1] = (h16)v[1]; hv[2] = (h16)v[2]; hv[3] = (h16)v[3]; *(h16x4*)(op + 16 * dt) = hv; } }
    lds_wait();
#pragma unroll 1
    for (int q = 0; q < 16; ++q) {
        const int t = t0 + q, cur = t >> 6, nsel = (cur + 1) < 16 ? (cur + 1) : 16;
        unsigned key[4];
#pragma unroll
        for (int c = 0; c < 4; ++c) { const int j = lane + 64 * c; const float v = psl[q * 260 + j];
            const bool val = j <= cur, forced = (j == 0) || (j == cur) || (j == cur - 1);
            const unsigned kb = forced ? 0xFFFFFF00u : (__float_as_uint(v) & 0xFFFFFF00u);
            key[c] = val ? (kb | (unsigned)(255 - j)) : 0u; }
        int myj = 0;
#pragma unroll 1
        for (int it = 0; it < nsel; ++it) {
            const unsigned loc = max(max(key[0], key[1]), max(key[2], key[3]));
            const unsigned W = wave_umax(loc);
            const int js = 255 - (int)(W & 255u);
            if (lane == it) myj = js;
#pragma unroll
            for (int c = 0; c < 4; ++c) key[c] = (key[c] == W) ? 0u : key[c];
        }
        if (lane < 16) ((unsigned char*)(C.ws + WS_IDX))[((size_t)t * 2 + g) * 16 + lane] = (unsigned char)myj;
    }
    lds_wait();
}

__device__ __forceinline__ void gate_unit(Ctx& C, int t0) {
    const int lane = C.lane, fr = lane & 15, fq = lane >> 4;
    const h16* xh = (const h16*)(C.ws + WS_R1) + (size_t)(t0 + fr) * D + 8 * fq; const h16* wg = (const h16*)(C.ws + WS_WG) + (size_t)fr * D + 8 * fq;
    f32x4 a0 = (f32x4){0.f, 0.f, 0.f, 0.f}, a1 = a0;
#pragma unroll 4
    for (int k = 0; k < D; k += 32) { const h16x8 xa = *(const h16x8*)(xh + k); const h16x8 w0 = *(const h16x8*)(wg + k), w1 = *(const h16x8*)(wg + (size_t)16 * D + k);
        a0 = MFMA16(xa, w0, a0); a1 = MFMA16(xa, w1, a1); }
    const float* rstd = (const float*)(C.ws + WS_RSTDX); float* GS = (float*)(C.ws + WS_GS);
#pragma unroll
    for (int r = 0; r < 4; ++r) { const int t = t0 + 4 * fq + r; const float rs = rstd[t];
        GS[(size_t)t * 24 + fr] = sigmoidf_(a0[r] * rs); if (fr < 8) GS[(size_t)t * 24 + 16 + fr] = sigmoidf_(a1[r] * rs); }
}

__device__ __forceinline__ void phase3_mfma(Ctx& C) {
    LDSP float* tabw = (LDSP float*)(C.lds);
    LDSP float* tabs = (LDSP float*)(C.lds + 17408);
    LDSP float* psl = (LDSP float*)(C.lds + 22528 + C.wave * 16640);
    build_band_table(C, tabw, 544, 0); build_band_table(C, tabw + 544 * 4, 544, 4);
    build_band_table(C, tabs, 160, 8); build_band_table(C, tabs + 160 * 4, 160, 12);
    __syncthreads();
    constexpr int NT = S / 16;
    const int NU = NT * 2   + NT * 2   + NT * 2   + NT  ;
    for (int u = C.gw; u < NU; u += C.NGW) {
        int r = u;
        if (r < NT * 2) { const int tile = NT - 1 - (r >> 1), g = r & 1; for (int rr = 0; rr < 1 + ((REP3 >> 0) & 1); ++rr) cmp_unit(C, tile * 16, g, psl); continue; } r -= NT * 2;
        if (r < NT * 2) { for (int rr = 0; rr < 1 + ((REP3 >> 1) & 1); ++rr) band_unit<2>(C, (r >> 1) * 16, r & 1, tabw + (r & 1) * 544 * 4, 544, (h16*)(C.ws + WS_OW)); continue; } r -= NT * 2;
        if (r < NT * 2) { for (int rr = 0; rr < 1 + ((REP3 >> 2) & 1); ++rr) band_unit<3>(C, (r >> 1) * 16, r & 1, tabs + (r & 1) * 160 * 4, 160, (h16*)(C.ws + WS_OB)); continue; } r -= NT * 2;
        gate_unit(C, r * 16);
    }
}

__device__ __forceinline__ float gelu_tanh(float x) { const float u = 0.7978845608028654f * (x + 0.044715f * x * x * x); return 0.5f * x * (1.0f + tanhf(u)); }
__device__ __forceinline__ void phase2_mfma(Ctx& C) {
    const int lane = C.lane, fr = lane & 15, fq = lane >> 4, w = C.wave;
    LDSP float* biasl = (LDSP float*)C.lds;
    LDSP float* part = (LDSP float*)(C.lds + 2048);
    const float* cbp = (const float*)(C.ws + WS_CBP);
    { const int i = C.tid; float b = 0.f; for (int s = 0; s < 16; ++s) b += cbp[(s * 2 + (i >> 8)) * 256 + (i & 255)]; biasl[i] = b; }
    __syncthreads();
    const h16* proj = (const h16*)(C.ws + WS_R0);
    for (int u = blockIdx.x; u < 256; u += gridDim.x) {
        const int kv = u >> 7, g = (u >> 6) & 1, i0 = (u & 63) * 16;
        const h16* w1T = (const h16*)(C.ws + (kv ? WS_CW1V : WS_CW1K)); const h16* w2T = (const h16*)(C.ws + (kv ? WS_CW2V : WS_CW2K));
        const int col = (kv ? C_VC : C_KC) + g * 64;
        int irow = i0 + fr; irow = irow > NCMP - 1 ? NCMP - 1 : irow;
        const h16* xb = proj + (size_t)(16 * irow) * PP + col + 8 * fq;
        const h16* wa0 = w1T + (size_t)(32 * w + fr) * 2048 + 8 * fq; const h16* wa1 = wa0 + (size_t)16 * 2048;
        f32x4 a0 = (f32x4){0.f, 0.f, 0.f, 0.f}, a1 = a0;
#pragma unroll 8
        for (int ks = 0; ks < 64; ++ks) {
            const h16x8 xv = *(const h16x8*)(xb + (size_t)(ks >> 1) * PP + (ks & 1) * 32);
            const h16x8 wv0 = *(const h16x8*)(wa0 + 32 * ks), wv1 = *(const h16x8*)(wa1 + 32 * ks);
            a0 = MFMA16(wv0, xv, a0); a1 = MFMA16(wv1, xv, a1);
        }
#pragma unroll
        for (int r = 0; r < 4; ++r) { a0[r] = gelu_tanh(a0[r] + biasl[kv * 256 + 32 * w + 4 * fq + r]); a1[r] = gelu_tanh(a1[r] + biasl[kv * 256 + 32 * w + 16 + 4 * fq + r]); }
        const h16x8 hf = pack_p(a0, a1);
#pragma unroll
        for (int ot = 0; ot < 4; ++ot) { const h16* wr = w2T + (size_t)(16 * ot + fr) * 256 + 32 * w + 4 * fq;
            const h16x8 wf = cat44(*(const h16x4*)wr, *(const h16x4*)(wr + 16));
            f32x4 o = (f32x4){0.f, 0.f, 0.f, 0.f}; o = MFMA16(wf, hf, o);
#pragma unroll
            for (int r = 0; r < 4; ++r) part[(w * 64 + 16 * ot + 4 * fq + r) * 16 + fr] = o[r]; }
        __syncthreads();
#pragma unroll
        for (int e = 0; e < 2; ++e) { const int idx = C.tid + 512 * e, o = idx >> 4, rr = idx & 15; float s = 0.f;
#pragma unroll
            for (int ww = 0; ww < 8; ++ww) s += part[(ww * 64 + o) * 16 + rr];
            const int i = i0 + rr;
            if (i < NCMP) { if (kv == 0) ((h16*)(C.ws + WS_KC))[((size_t)g * 1024 + i) * 64 + o] = (h16)s;
                            else ((h16*)(C.ws + WS_VCT))[((size_t)((g * 16 + (i >> 6)) * 64 + o)) * 64 + (i & 63)] = (h16)s; } }
        __syncthreads();
    }
}

__device__ __forceinline__ void build_sel_table(Ctx& C, LDSP unsigned char* buck, LDSP float* biasl) {
    for (int i = C.tid; i < 1024; i += NTHR) buck[i] = (unsigned char)t5_bucket(i);
    if (C.tid < 256) biasl[C.tid] = C.in[13][(C.tid >> 3) * 16 + (C.tid & 7)];
}
__device__ __forceinline__ void sel_block(int blk, int cur, unsigned mk, const LDSP unsigned char* Kb, const LDSP unsigned char* Vb, const LDSP unsigned char* buck, const LDSP float* biasg, const h16x8 (&qf)[2][2],
                                          f32x4 (&O)[2][4], float (&m)[2], float (&l)[2], int tq0, int fr, int fq, int qi, int hd, float bfar) {
    h16x8 kf[4][2];
    const int sw = fr & 7;
#pragma unroll
    for (int T = 0; T < 4; ++T)
#pragma unroll
        for (int ks = 0; ks < 2; ++ks) kf[T][ks] = *(const LDSP h16x8*)(Kb + (16 * T + fr) * 128 + (((4 * ks + fq) ^ sw) << 4));
    const bool far = (tq0 - (blk * 64 + 63)) >= 790;
#pragma unroll
    for (int c = 0; c < 2; ++c) {
        if (((mk >> (4 * c)) & 15u) == 0u) continue;
        f32x4 Sx[4];
#pragma unroll
        for (int T = 0; T < 4; ++T) { f32x4 z = (f32x4){0.f, 0.f, 0.f, 0.f}; z = MFMA16(kf[T][0], qf[c][0], z); Sx[T] = MFMA16(kf[T][1], qf[c][1], z); }
        const int tq = tq0 + 4 * c + qi; const bool qsel = ((mk >> (4 * c + qi)) & 1u) != 0u;
        float tm = -INFINITY;
        if (far) {
            const float add = qsel ? bfar : -INFINITY;
#pragma unroll
            for (int T = 0; T < 4; ++T)
#pragma unroll
                for (int r = 0; r < 4; ++r) { float s; asm("v_fma_f32 %0, %1, %2, %3" : "=v"(s) : "v"(Sx[T][r]), "s"(0.125f), "v"(add)); Sx[T][r] = s; tm = fmaxf(tm, s); }
        } else {
#pragma unroll
            for (int T = 0; T < 4; ++T)
#pragma unroll
                for (int r = 0; r < 4; ++r) { const int dist = tq - (blk * 64 + 16 * T + 4 * fq + r);
                    const int dc = dist < 0 ? 0 : (dist > 1023 ? 1023 : dist); const float b = biasg[(int)buck[dc] * 8 + hd];
                    const float s = (qsel && dist >= 0) ? Sx[T][r] * 0.125f + b : -INFINITY; Sx[T][r] = s; tm = fmaxf(tm, s); }
        }
        tm = xmax4(tm);
        const float mn = fmaxf(m[c], tm), ms = (mn == -INFINITY) ? 0.f : mn;
        if (__builtin_amdgcn_ballot_w64(mn != m[c]) != 0ull) {
            const float alpha = __expf(m[c] - ms); l[c] *= alpha;
#pragma unroll
            for (int dt = 0; dt < 4; ++dt) O[c][dt] = O[c][dt] * alpha;
            m[c] = mn;
        }
        float ps = 0.f;
#pragma unroll
        for (int T = 0; T < 4; ++T)
#pragma unroll
            for (int r = 0; r < 4; ++r) { const float e = __expf(Sx[T][r] - ms); Sx[T][r] = e; ps += e; }
        l[c] += ps;
        const h16x8 p0 = pack_p(Sx[0], Sx[1]), p1 = pack_p(Sx[2], Sx[3]);
#pragma unroll
        for (int dt = 0; dt < 4; ++dt) { const LDSP unsigned char* vr = Vb + (16 * dt + fr) * 128 + (fq & 1) * 8; const int c0 = fq >> 1;
            const h16x8 v0 = cat44(*(const LDSP h16x4*)(vr + (((c0) ^ sw) << 4)), *(const LDSP h16x4*)(vr + (((c0 + 2) ^ sw) << 4)));
            const h16x8 v1 = cat44(*(const LDSP h16x4*)(vr + (((c0 + 4) ^ sw) << 4)), *(const LDSP h16x4*)(vr + (((c0 + 6) ^ sw) << 4)));
            O[c][dt] = MFMA16(v0, p0, O[c][dt]); O[c][dt] = MFMA16(v1, p1, O[c][dt]); }
    }
}
__device__ __forceinline__ void sel_wg_unit(Ctx& C, int qb, int g, LDSP unsigned char* bufs  , const LDSP unsigned char* buck, const LDSP float* biasg, LDSP unsigned* mskw  ) {
    const int lane = C.lane, fr = lane & 15, fq = lane >> 4, qi = fr >> 2, hd = fr & 3, w = C.wave;
    const h16* proj = (const h16*)(C.ws + WS_R0);
    const int tq0 = qb * 64 + 8 * w;
    for (int i = lane; i < 256; i += 64) mskw[i] = 0u;
    lds_wait();
    {
        const int nsel = (qb + 1) < 16 ? (qb + 1) : 16;
#pragma unroll
        for (int e2 = 0; e2 < 2; ++e2) { const int e = lane + 64 * e2, q = e >> 4, slot = e & 15;
            if (slot < nsel) { const int j = ((const unsigned char*)(C.ws + WS_IDX))[((size_t)(tq0 + q) * 2 + g) * 16 + slot]; atomicOr((unsigned*)(mskw + j), 1u << q); } }
    }
    lds_wait();
    h16x8 qf[2][2];
#pragma unroll
    for (int c = 0; c < 2; ++c)
#pragma unroll
        for (int ks = 0; ks < 2; ++ks) qf[c][ks] = *(const h16x8*)(proj + (size_t)(tq0 + 4 * c + qi) * PP + C_QN + (g * 4 + hd) * 64 + 32 * ks + 8 * fq);
    f32x4 O[2][4]; float m[2], l[2];
#pragma unroll
    for (int c = 0; c < 2; ++c) { m[c] = -INFINITY; l[c] = 0.f;
#pragma unroll
        for (int dt = 0; dt < 4; ++dt) O[c][dt] = (f32x4){0.f, 0.f, 0.f, 0.f}; }
    const float bfar = C.in[13][31 * 16 + g * 4 + hd];
    const int rl = lane >> 3, cg = (lane & 7) ^ rl;
    const h16* ksrc = (const h16*)(C.ws + WS_KS) + (size_t)g * S * 64 + (8 * w + rl) * 64 + cg * 8;
    const h16* vsrc = (const h16*)(C.ws + WS_VST) + (size_t)g * S * 64 + (8 * w + rl) * 64 + cg * 8;
    LDSP unsigned char* ringw = bufs + w * 1024;
#define SEL_DMA(b) do { const int b_ = (b) <= qb ? (b) : qb; LDSP unsigned char* d_ = ringw + ((b) & 7) * 16384; \
        __builtin_amdgcn_global_load_lds((const unsigned*)(ksrc + (size_t)b_ * 4096), (LDSP unsigned*)d_, 16, 0, 0); \
        __builtin_amdgcn_global_load_lds((const unsigned*)(vsrc + (size_t)b_ * 4096), (LDSP unsigned*)(d_ + 8192), 16, 0, 0); } while (0)
    asm volatile("s_waitcnt vmcnt(0)" ::: "memory");
    SEL_DMA(0); SEL_DMA(1); SEL_DMA(2); SEL_DMA(3);
#pragma unroll 1
    for (int b0 = 0; b0 <= qb; b0 += 4) {
        asm volatile("s_waitcnt vmcnt(0) lgkmcnt(0)" ::: "memory");
        __builtin_amdgcn_s_barrier(); asm volatile("" ::: "memory");
        if (b0 + 4 <= qb) { SEL_DMA(b0 + 4); SEL_DMA(b0 + 5); SEL_DMA(b0 + 6); SEL_DMA(b0 + 7); }
#pragma unroll 1
        for (int j = 0; j < 4; ++j) { const int blk = b0 + j; if (blk > qb) break;
            const unsigned mk = (unsigned)__builtin_amdgcn_readfirstlane((int)mskw[blk]);
            if (mk != 0u) { const LDSP unsigned char* kc_ = bufs + (blk & 7) * 16384; sel_block(blk, qb, mk, kc_, kc_ + 8192, buck, biasg, qf, O, m, l, tq0, fr, fq, qi, hd, bfar); } }
    }
    asm volatile("s_waitcnt vmcnt(0)" ::: "memory");
#undef SEL_DMA
    const float* GS = (const float*)(C.ws + WS_GS); h16* oa = (h16*)(C.ws + WS_OA); const h16* ow = (const h16*)(C.ws + WS_OW);
#pragma unroll
    for (int c = 0; c < 2; ++c) {
        const int t = tq0 + 4 * c + qi; const float inv = 1.0f / fmaxf(xsum4(l[c]), 1e-30f);
        const float g0 = GS[(size_t)t * 24 + g * 12 + hd * 3 + 0], g1 = GS[(size_t)t * 24 + g * 12 + hd * 3 + 1], g2 = GS[(size_t)t * 24 + g * 12 + hd * 3 + 2];
        const size_t base = (size_t)t * 512 + (g * 4 + hd) * 64 + 4 * fq;
#pragma unroll
        for (int dt = 0; dt < 4; ++dt) { const h16x4 cv = *(const h16x4*)(oa + base + 16 * dt), wv = *(const h16x4*)(ow + base + 16 * dt); h16x4 o;
#pragma unroll
            for (int r = 0; r < 4; ++r) o[r] = (h16)(g0 * (float)cv[r] + g1 * (O[c][dt][r] * inv) + g2 * (float)wv[r]);
            if (!C.nowrite) *(h16x4*)(oa + base + 16 * dt) = o; }
    }
    __syncthreads();
}
__device__ __forceinline__ void phase4_mfma(Ctx& C) {
    LDSP unsigned char* bufs = C.lds;
    LDSP unsigned char* buck = C.lds + 131072;
    LDSP float* biasl = (LDSP float*)(C.lds + 131072 + 1024);
    LDSP unsigned* msk = (LDSP unsigned*)(C.lds + 131072 + 2048);
    build_sel_table(C, buck, biasl);
    __syncthreads();
    for (int u = blockIdx.x; u < 512; u += gridDim.x) {
        const int qb = (u < 256) ? (u >> 1) : (255 - ((u - 256) >> 1)), g = u & 1;
        sel_wg_unit(C, qb, g, bufs, buck, biasl + g * 4, msk + C.wave * 256);
    }
}

__device__ __forceinline__ void phase_rows1(Ctx& C) {
    const float* z = (const float*)(C.ws + WS_R0); h16* h1h = (h16*)(C.ws + WS_R1); float* rstd1 = (float*)(C.ws + WS_RSTD1);
    for (int m = C.gw; m < S; m += C.NGW) {
        const f32x4* zr = (const f32x4*)(z + (size_t)m * D) + C.lane; const f32x4* xr = (const f32x4*)(C.in[0] + (size_t)m * D) + C.lane; const f32x4* gr = (const f32x4*)C.in[2] + C.lane;
        f32x4 v[4]; float s = 0.f;
#pragma unroll
        for (int j = 0; j < 4; ++j) { v[j] = zr[64 * j]; s += (v[j].x * v[j].x + v[j].y * v[j].y) + (v[j].z * v[j].z + v[j].w * v[j].w); }
        const float rs = 1.0f / sqrtf(wave_sum(s) * (1.0f / D) + EPS); float s2 = 0.f;
#pragma unroll
        for (int j = 0; j < 4; ++j) { v[j] = xr[64 * j] + v[j] * rs * gr[64 * j]; s2 += (v[j].x * v[j].x + v[j].y * v[j].y) + (v[j].z * v[j].z + v[j].w * v[j].w); }
        s2 = wave_sum(s2);
        if (C.lane == 0) rstd1[m] = 1.0f / sqrtf(s2 * (1.0f / D) + EPS);
        f32x4* orow = (f32x4*)(C.out + (size_t)m * D) + C.lane; unsigned long long* o8 = (unsigned long long*)(h1h + (size_t)m * D) + C.lane;
#pragma unroll
        for (int j = 0; j < 4; ++j) { orow[64 * j] = v[j]; o8[64 * j] = (unsigned long long)pkh(v[j].x, v[j].y) | ((unsigned long long)pkh(v[j].z, v[j].w) << 32); }
    }
}
__device__ __forceinline__ void phase_rows2(Ctx& C) {
    const float* z = (const float*)(C.ws + WS_Z2);
    for (int m = C.gw; m < S; m += C.NGW) {
        const f32x4* zr = (const f32x4*)(z + (size_t)m * D) + C.lane; f32x4* orow = (f32x4*)(C.out + (size_t)m * D) + C.lane; const f32x4* gr = (const f32x4*)C.in[4] + C.lane;
        f32x4 v[4]; float s = 0.f;
#pragma unroll
        for (int j = 0; j < 4; ++j) { v[j] = zr[64 * j]; s += (v[j].x * v[j].x + v[j].y * v[j].y) + (v[j].z * v[j].z + v[j].w * v[j].w); }
        const float rs = 1.0f / sqrtf(wave_sum(s) * (1.0f / D) + EPS);
#pragma unroll
        for (int j = 0; j < 4; ++j) orow[64 * j] = orow[64 * j] + v[j] * rs * gr[64 * j];
    }
}

constexpr int NPHASE = 11;
__global__ void __launch_bounds__(NTHR, 2) fwd_kernel(Args args) {
    extern __shared__ __attribute__((aligned(16))) unsigned char lds_raw[];
    Ctx C;
    C.lds = (LDSP unsigned char*)lds_raw; C.tid = threadIdx.x; C.lane = C.tid & 63; C.wave = __builtin_amdgcn_readfirstlane(C.tid >> 6);
    C.gw = blockIdx.x * NWAVES + C.wave; C.NGW = gridDim.x * NWAVES;
#pragma unroll
    for (int i = 0; i < 19; ++i) C.in[i] = args.in[i];
    C.out = args.out; C.ws = args.ws; C.nowrite = args.pad;
    const int lo = args.ph_lo, hi = args.ph_hi;
    unsigned char* ws = args.ws;
#define IN(k) (lo <= (k) && (k) < hi)
#define SEAM(k) do { if (IN(k) && IN((k) + 1)) { if (args.coop) { cg::this_grid().sync(); } } } while (0)
    if (IN(0)) { phase_prologue(C); } SEAM(0);
    if (IN(1)) { pg8::Gemm g{(const h16*)(ws + WS_R1), (const h16*)(ws + WS_WIN), S, 4096, D}; pg8::StaticOrder So; So.init(S, 4096, (int)gridDim.x, (int)blockIdx.x);
        pg8::EpiProjF E{(h16*)(ws + WS_R0), (const float*)(ws + WS_RSTDX), ws};
        pg8::gemm_phase<pg8::EpiProjF, pg8::StaticOrder, true, true>(C.lds, g, So, E); } SEAM(1);
    if (IN(2)) { __syncthreads(); phase2_mfma(C); } SEAM(2);
    if (IN(3)) { __syncthreads(); phase3_mfma(C); } SEAM(3);
    if (IN(4)) { __syncthreads(); phase4_mfma(C); } SEAM(4);
    if (IN(5)) { pg8::StaticOrder So; So.init(S, D, (int)gridDim.x, (int)blockIdx.x);
        { pg8::Gemm g{(const h16*)(ws + WS_OA), (const h16*)(ws + WS_WUA), S, D, 512}; pg8::EpiUpF<0> E{(h16*)(ws + WS_R1), (const h16*)(ws + WS_R0) + C_GA};
          pg8::gemm_phase<pg8::EpiUpF<0>, pg8::StaticOrder, false, true>(C.lds, g, So, E); }
        { pg8::Gemm g{(const h16*)(ws + WS_OB), (const h16*)(ws + WS_WUB), S, D, 512}; pg8::EpiUpF<1> E{(h16*)(ws + WS_R1), (const h16*)(ws + WS_R0) + C_GB};
          pg8::gemm_phase<pg8::EpiUpF<1>, pg8::StaticOrder, false, true>(C.lds, g, So, E); } } SEAM(5);
    if (IN(6)) { pg8::Gemm g{(const h16*)(ws + WS_R1), (const h16*)(ws + WS_WOUT), S, D, D}; pg8::StaticOrder So; So.init(S, D, (int)gridDim.x, (int)blockIdx.x);
        pg8::EpiF32F E{(float*)(ws + WS_R0), D};
        pg8::gemm_phase<pg8::EpiF32F, pg8::StaticOrder, false, true>(C.lds, g, So, E); } SEAM(6);
    if (IN(7)) { phase_rows1(C); } SEAM(7);
    if (IN(8)) { pg8::Gemm g{(const h16*)(ws + WS_R1), (const h16*)(ws + WS_W1), S, FF, D}; pg8::StaticOrder So; So.init(S, FF, (int)gridDim.x, (int)blockIdx.x);
        pg8::EpiRelu2F E{(h16*)(ws + WS_R0), (const float*)(ws + WS_RSTD1)};
        pg8::gemm_phase<pg8::EpiRelu2F, pg8::StaticOrder, true, true>(C.lds, g, So, E); } SEAM(8);
    if (IN(9)) { pg8::Gemm g{(const h16*)(ws + WS_R0), (const h16*)(ws + WS_W2), S, D, FF}; pg8::StaticOrder So; So.init(S, D, (int)gridDim.x, (int)blockIdx.x);
        pg8::EpiF32F E{(float*)(ws + WS_Z2), D};
        pg8::gemm_phase<pg8::EpiF32F, pg8::StaticOrder, false, true>(C.lds, g, So, E); } SEAM(9);
    if (IN(10)) { phase_rows2(C); }
#undef IN
#undef SEAM
}

extern "C" void kernel_launch(void* const* d_in, const int* in_sizes, int n_in, void* d_out, int out_size, void* d_ws, size_t ws_size, hipStream_t stream) {
    static int grid = 0;
    if (grid == 0) {
        int dev = 0, cus = 0, per_cu = 0;
        hipGetDevice(&dev);
        hipDeviceGetAttribute(&cus, hipDeviceAttributeMultiprocessorCount, dev);
        hipFuncSetAttribute((const void*)fwd_kernel, hipFuncAttributeMaxDynamicSharedMemorySize, LDS_BYTES);
        hipOccupancyMaxActiveBlocksPerMultiprocessor(&per_cu, (const void*)fwd_kernel, NTHR, LDS_BYTES);
        if (per_cu < 1) { fprintf(stderr, "occupancy query says %d blocks/CU\n", per_cu); per_cu = 1; }
        grid = cus * 1;
        (void)hipGetLastError();
    }
    Args a{};
    for (int i = 0; i < 19; ++i) a.in[i] = (const float*)d_in[i];
    a.out = (float*)d_out; a.ws = (unsigned char*)d_ws;
#if N_LAUNCH_MODE == 1
    a.ph_lo = 0; a.ph_hi = NPHASE; a.coop = 1;
    void* kargs[] = {&a};
    hipError_t e = hipLaunchCooperativeKernel((const void*)fwd_kernel, dim3(grid), dim3(NTHR), kargs, LDS_BYTES, stream);
    if (e != hipSuccess) fprintf(stderr, "cooperative launch failed: %s (grid %d)\n", hipGetErrorString(e), grid);
#else
    for (int p = 0; p < NPHASE; ++p) {
        a.ph_lo = p; a.ph_hi = p + 1; a.coop = 0;
        hipLaunchKernelGGL(fwd_kernel, dim3(grid), dim3(NTHR), LDS_BYTES, stream, a);
        if ((REP_MASK >> p) & 1) { a.pad = (p == 4) ? 1 : 0; hipLaunchKernelGGL(fwd_kernel, dim3(grid), dim3(NTHR), LDS_BYTES, stream, a); a.pad = 0; }
    }
#endif
}
```
